# Optimizing an MI355X kernel written in HIP

```python
import math
import jax, jax.numpy as jnp
from jax import lax
import numpy as np

D_MODEL = 2048
BATCH = 2
SEQ = 4096
DEPTH = 1
DEC_BATCH = 16
DEC_SEQ = 16
PAST_LEN = 2048

CHUNK = 64
ATTN_WIDTH = D_MODEL // 2
LRU_WIDTH = D_MODEL - ATTN_WIDTH
HEAD_DIM = 128
HALF_DIM = HEAD_DIM // 2
N_HEADS = ATTN_WIDTH // HEAD_DIM
LRU_BLOCKS = 16
LRU_BLOCK_DIM = LRU_WIDTH // LRU_BLOCKS
CONV_WIDTH = 4
LRU_C = 8.0
D_FF = 4 * D_MODEL
ROPE_THETA = 10000.0
Q_BLOCK = 128
LN_EPS = 1e-5
RMS_EPS = 1e-5
NEG_INF = -1e30
DEEPNORM_ALPHA = (2.0 * DEPTH) ** 0.25
DEEPNORM_BETA = (8.0 * DEPTH) ** -0.25
IN_COLS = 3 * ATTN_WIDTH + 2 * LRU_WIDTH

kernel_name = "hymba_diffattn_rglru_deepnorm_stream_step"


def lambda_init(layer):
    return 0.8 - 0.6 * math.exp(-0.3 * layer)


def layer_norm(x, g, b):
    xf = x.astype(jnp.float32)
    mu = jnp.mean(xf, -1, keepdims=True)
    var = jnp.mean(jnp.square(xf - mu), -1, keepdims=True)
    y = (xf - mu) * lax.rsqrt(var + LN_EPS) * g.astype(jnp.float32) + b.astype(jnp.float32)
    return y.astype(x.dtype)


def rope(x, pos):
    inv = ROPE_THETA ** (-jnp.arange(0, HALF_DIM, 2, dtype=jnp.float32) / HALF_DIM)
    ang = pos.astype(jnp.float32)[:, None] * inv[None, :]
    cos = jnp.concatenate([jnp.cos(ang), jnp.cos(ang)], -1)[:, None, None, :]
    sin = jnp.concatenate([jnp.sin(ang), jnp.sin(ang)], -1)[:, None, None, :]
    x1, x2 = jnp.split(x.astype(jnp.float32), 2, axis=-1)
    rot = jnp.concatenate([-x2, x1], -1)
    return (x.astype(jnp.float32) * cos + rot * sin).astype(x.dtype)


def diff_attn_prompt(q, k, v, lam):
    B, S = q.shape[0], q.shape[1]
    nblk = S // Q_BLOCK
    k_chunk = jnp.arange(S) // CHUNK
    qb = q.reshape(B, nblk, Q_BLOCK, N_HEADS, 2, HALF_DIM).transpose(1, 0, 2, 3, 4, 5)
    scale = HALF_DIM ** -0.5

    def block(args):
        q_blk, i = args
        s = jnp.einsum('bqhcd,bkhcd->bhcqk', q_blk, k).astype(jnp.float32) * scale
        q_chunk = (i * Q_BLOCK + jnp.arange(Q_BLOCK)) // CHUNK
        mask = q_chunk[:, None] >= k_chunk[None, :]
        p = jax.nn.softmax(jnp.where(mask, s, NEG_INF), axis=-1)
        w = p[:, :, 0] - lam * p[:, :, 1]
        return jnp.einsum('bhqk,bkhe->bqhe', w.astype(v.dtype), v)

    o = lax.map(block, (qb, jnp.arange(nblk)))
    return o.transpose(1, 0, 2, 3, 4).reshape(B, S, N_HEADS, HEAD_DIM)


def diff_attn_sample(q, k, v, cache_k, cache_v, lam):
    B, P = cache_k.shape[0], cache_k.shape[1]
    k_all = jnp.concatenate([cache_k.reshape(B, P, N_HEADS, 2, HALF_DIM), k], axis=1)
    v_all = jnp.concatenate([cache_v, v], axis=1)
    s = jnp.einsum('bqhcd,bkhcd->bhcqk', q, k_all).astype(jnp.float32) * HALF_DIM ** -0.5
    p = jax.nn.softmax(s, axis=-1)
    w = p[:, :, 0] - lam * p[:, :, 1]
    return jnp.einsum('bhqk,bkhe->bqhe', w.astype(v_all.dtype), v_all)


def causal_conv(xb, buf, w, b):
    T = xb.shape[1]
    xp = jnp.concatenate([buf, xb], axis=1)
    y = b + sum(xp[:, j:j + T] * w[j] for j in range(CONV_WIDTH))
    return y, xp[:, -(CONV_WIDTH - 1):]


def rg_lru(xc, h0, w_a, b_a, w_i, b_i, lru_lambda):
    B, T = xc.shape[0], xc.shape[1]
    xr = xc.reshape(B, T, LRU_BLOCKS, LRU_BLOCK_DIM)
    r = jax.nn.sigmoid(jnp.einsum('bthi,hij->bthj', xr, w_a).reshape(B, T, LRU_WIDTH) + b_a)
    ig = jax.nn.sigmoid(jnp.einsum('bthi,hij->bthj', xr, w_i).reshape(B, T, LRU_WIDTH) + b_i)
    log_a = -LRU_C * r.astype(jnp.float32) * jax.nn.softplus(-lru_lambda.astype(jnp.float32))
    a = jnp.exp(log_a)
    u = jnp.sqrt(-jnp.expm1(2.0 * log_a)) * (ig * xc).astype(jnp.float32)

    def step(h, au):
        a_t, u_t = au
        h = a_t * h + u_t
        return h, h

    h_last, hs = lax.scan(step, h0.astype(jnp.float32), (a.transpose(1, 0, 2), u.transpose(1, 0, 2)))
    return hs.transpose(1, 0, 2).astype(xc.dtype), h_last.astype(h0.dtype)


def trunk_layer(x, pos, cache_k, cache_v, conv_buf, h0, p, lam_init):
    B, T = x.shape[0], x.shape[1]
    proj = x @ p['w_in']
    q, k, v, xb, g = jnp.split(proj, [ATTN_WIDTH, 2 * ATTN_WIDTH, 3 * ATTN_WIDTH, 3 * ATTN_WIDTH + LRU_WIDTH], axis=-1)
    q = rope(q.reshape(B, T, N_HEADS, 2, HALF_DIM), pos)
    k = rope(k.reshape(B, T, N_HEADS, 2, HALF_DIM), pos)
    v = v.reshape(B, T, N_HEADS, HEAD_DIM)
    lam = (jnp.exp(jnp.sum(p['lambda_q1'].astype(jnp.float32) * p['lambda_k1'].astype(jnp.float32)))
           - jnp.exp(jnp.sum(p['lambda_q2'].astype(jnp.float32) * p['lambda_k2'].astype(jnp.float32)))
           + lam_init)
    if cache_k is None:
        o = diff_attn_prompt(q, k, v, lam)
    else:
        o = diff_attn_sample(q, k, v, cache_k, cache_v, lam)
    of = o.astype(jnp.float32)
    of = of * lax.rsqrt(jnp.mean(of * of, -1, keepdims=True) + RMS_EPS) * p['subln_g'].astype(jnp.float32)
    o_attn = (of * (1.0 - lam_init)).astype(x.dtype).reshape(B, T, ATTN_WIDTH)
    xc, new_buf = causal_conv(xb, conv_buf, p['conv_w'], p['conv_b'])
    hs, h_last = rg_lru(xc, h0, p['w_rg_a'], p['b_rg_a'], p['w_rg_i'], p['b_rg_i'], p['lru_lambda'])
    o_lru = hs * jax.nn.gelu(g)
    mix = jnp.concatenate([o_attn, o_lru], axis=-1) @ p['w_out']
    x = layer_norm(DEEPNORM_ALPHA * x + mix, p['ln1_g'], p['ln1_b'])
    ffn = jnp.square(jax.nn.relu(x @ p['w_up'])) @ p['w_down']
    x = layer_norm(DEEPNORM_ALPHA * x + ffn, p['ln2_g'], p['ln2_b'])
    return x, k.reshape(B, T, N_HEADS, HEAD_DIM), v, h_last, new_buf


def setup_inputs(seed: int = 0) -> dict:
    key = jax.random.key(seed)
    ks = jax.random.split(key, 24)
    f32 = jnp.float32
    nrm = lambda k, shape, s: jax.random.normal(k, shape, f32) * s
    col_scale = jnp.concatenate([jnp.ones((2 * ATTN_WIDTH,), f32),
                                 jnp.full((ATTN_WIDTH,), DEEPNORM_BETA, f32),
                                 jnp.ones((2 * LRU_WIDTH,), f32)])
    a0 = jax.random.uniform(ks[13], (DEPTH, LRU_WIDTH), f32, 0.9, 0.999)
    return {
        'x_prompt': nrm(ks[0], (BATCH, SEQ, D_MODEL), 1.0),
        'x_sample': nrm(ks[1], (DEC_BATCH, DEC_SEQ, D_MODEL), 1.0),
        'cache_k': nrm(ks[2], (DEPTH, DEC_BATCH, PAST_LEN, N_HEADS, HEAD_DIM), 1.0),
        'cache_v': nrm(ks[3], (DEPTH, DEC_BATCH, PAST_LEN, N_HEADS, HEAD_DIM), 1.0),
        'state_h': nrm(ks[4], (DEPTH, DEC_BATCH, LRU_WIDTH), 0.5),
        'state_conv': nrm(ks[5], (DEPTH, DEC_BATCH, CONV_WIDTH - 1, LRU_WIDTH), 1.0),
        'w_in': nrm(ks[6], (DEPTH, D_MODEL, IN_COLS), D_MODEL ** -0.5) * col_scale,
        'lambda_q1': nrm(ks[7], (DEPTH, HALF_DIM), 0.1),
        'lambda_k1': nrm(ks[8], (DEPTH, HALF_DIM), 0.1),
        'lambda_q2': nrm(ks[9], (DEPTH, HALF_DIM), 0.1),
        'lambda_k2': nrm(ks[10], (DEPTH, HALF_DIM), 0.1),
        'subln_g': 1.0 + nrm(ks[11], (DEPTH, HEAD_DIM), 0.01),
        'conv_w': nrm(ks[12], (DEPTH, CONV_WIDTH, LRU_WIDTH), CONV_WIDTH ** -0.5),
        'conv_b': nrm(ks[14], (DEPTH, LRU_WIDTH), 0.01),
        'w_rg_a': nrm(ks[15], (DEPTH, LRU_BLOCKS, LRU_BLOCK_DIM, LRU_BLOCK_DIM), LRU_BLOCK_DIM ** -0.5),
        'b_rg_a': nrm(ks[16], (DEPTH, LRU_WIDTH), 0.01),
        'w_rg_i': nrm(ks[17], (DEPTH, LRU_BLOCKS, LRU_BLOCK_DIM, LRU_BLOCK_DIM), LRU_BLOCK_DIM ** -0.5),
        'b_rg_i': nrm(ks[18], (DEPTH, LRU_WIDTH), 0.01),
        'lru_lambda': jnp.log(a0 / (1.0 - a0)),
        'w_out': nrm(ks[19], (DEPTH, D_MODEL, D_MODEL), D_MODEL ** -0.5 * DEEPNORM_BETA),
        'ln1_g': 1.0 + nrm(ks[20], (DEPTH, D_MODEL), 0.01),
        'ln1_b': nrm(ks[21], (DEPTH, D_MODEL), 0.01),
        'w_up': nrm(ks[22], (DEPTH, D_MODEL, D_FF), D_MODEL ** -0.5 * DEEPNORM_BETA),
        'w_down': nrm(ks[23], (DEPTH, D_FF, D_MODEL), D_FF ** -0.5 * DEEPNORM_BETA),
        'ln2_g': 1.0 + nrm(jax.random.fold_in(ks[20], 1), (DEPTH, D_MODEL), 0.01),
        'ln2_b': nrm(jax.random.fold_in(ks[21], 1), (DEPTH, D_MODEL), 0.01),
    }


def reference(x_prompt, x_sample, cache_k, cache_v, state_h, state_conv,
              w_in, lambda_q1, lambda_k1, lambda_q2, lambda_k2, subln_g,
              conv_w, conv_b, w_rg_a, b_rg_a, w_rg_i, b_rg_i, lru_lambda,
              w_out, ln1_g, ln1_b, w_up, w_down, ln2_g, ln2_b):
    B, S = x_prompt.shape[0], x_prompt.shape[1]
    T = x_sample.shape[1]
    P = cache_k.shape[2]
    pos_prompt = jnp.arange(S, dtype=jnp.int32)
    pos_sample = P + jnp.arange(T, dtype=jnp.int32)
    yp, ys = x_prompt, x_sample
    kp_l, vp_l, hp_l, cp_l, ks_l, vs_l, hs_l, cs_l = [], [], [], [], [], [], [], []
    for l in range(DEPTH):
        p = {'w_in': w_in[l], 'lambda_q1': lambda_q1[l], 'lambda_k1': lambda_k1[l],
             'lambda_q2': lambda_q2[l], 'lambda_k2': lambda_k2[l], 'subln_g': subln_g[l],
             'conv_w': conv_w[l], 'conv_b': conv_b[l], 'w_rg_a': w_rg_a[l], 'b_rg_a': b_rg_a[l],
             'w_rg_i': w_rg_i[l], 'b_rg_i': b_rg_i[l], 'lru_lambda': lru_lambda[l],
             'w_out': w_out[l], 'ln1_g': ln1_g[l], 'ln1_b': ln1_b[l],
             'w_up': w_up[l], 'w_down': w_down[l], 'ln2_g': ln2_g[l], 'ln2_b': ln2_b[l]}
        lam0 = lambda_init(l)
        zero_buf = jnp.zeros((B, CONV_WIDTH - 1, LRU_WIDTH), x_prompt.dtype)
        zero_h = jnp.zeros((B, LRU_WIDTH), state_h.dtype)
        yp, kp, vp, hp, cp = trunk_layer(yp, pos_prompt, None, None, zero_buf, zero_h, p, lam0)
        ys, kn, vn, hn, cn = trunk_layer(ys, pos_sample, cache_k[l], cache_v[l], state_conv[l], state_h[l], p, lam0)
        kp_l.append(kp); vp_l.append(vp); hp_l.append(hp); cp_l.append(cp)
        ks_l.append(kn); vs_l.append(vn); hs_l.append(hn); cs_l.append(cn)
    k_prompt = jnp.stack(kp_l); v_prompt = jnp.stack(vp_l)
    h_prompt = jnp.stack(hp_l); conv_prompt = jnp.stack(cp_l)
    k_sample = jnp.stack(ks_l); v_sample = jnp.stack(vs_l)
    h_sample = jnp.stack(hs_l); conv_sample = jnp.stack(cs_l)
    return (yp, ys, k_prompt, v_prompt, h_prompt, conv_prompt, k_sample, v_sample, h_sample, conv_sample)
```

```cpp
#include <hip/hip_runtime.h>
#include <hip/hip_cooperative_groups.h>
#include <cstdio>
#include <cstdint>
namespace cg = cooperative_groups;

#ifndef MK_N_LAUNCHES
#define MK_N_LAUNCHES 1
#endif

#define LAS __attribute__((address_space(3)))
typedef unsigned short bf16_t;
typedef short bf16x8 __attribute__((ext_vector_type(8)));
typedef short s16x4 __attribute__((ext_vector_type(4)));
typedef float f32x2 __attribute__((ext_vector_type(2)));
typedef float f32x4 __attribute__((ext_vector_type(4)));
typedef float f32x16 __attribute__((ext_vector_type(16)));
typedef unsigned u32x2 __attribute__((ext_vector_type(2)));
typedef unsigned u32x4 __attribute__((ext_vector_type(4)));

constexpr int DM = 2048, SEQ = 4096, NBP = 2, NBS = 16, TS = 16, PAST = 2048;
constexpr int MP = NBP * SEQ, MS = NBS * TS, MT = MP + MS;
constexpr int AW = 1024, LW = 1024, NH = 8, INC = 5120, DFF = 8192;
constexpr float LN_EPS = 1e-5f, RMS_EPS = 1e-5f;
constexpr float DN_ALPHA = 1.189207115002721f;
constexpr float LAM_INIT = 0.2f;
constexpr float QSCALE = 0.125f * 1.4426950408889634f;
constexpr float LOG2E = 1.4426950408889634f;

constexpr size_t O_YP = 0, O_YS = 16777216, O_KP = 17301504, O_VP = 25690112, O_HP = 34078720, O_CP = 34080768,
                 O_KS = 34086912, O_VS = 34349056, O_HS = 34611200, O_CS = 34627584, O_END = 34676736;

constexpr size_t MiB = 1u << 20;
constexpr size_t WS_CTL = 0, CTL_BYTES = 65536;
constexpr size_t WS_ROPE = 1 * MiB;
constexpr size_t WS_WIN = 3 * MiB;
constexpr size_t WS_WOUT = 23 * MiB;
constexpr size_t WS_WUP = 31 * MiB;
constexpr size_t WS_WDOWN = 63 * MiB;
constexpr size_t WS_XB = 95 * MiB;
constexpr size_t WS_QP = 128 * MiB;
constexpr size_t WS_KP = 144 * MiB;
constexpr size_t WS_VP = 160 * MiB;
constexpr size_t WS_QS = 176 * MiB;
constexpr size_t WS_XBR = 177 * MiB;
constexpr size_t WS_GB = 210 * MiB;
constexpr size_t WS_CAT = 227 * MiB;
constexpr size_t WS_Y1 = 260 * MiB;
constexpr size_t WS_X1B = 326 * MiB;
constexpr size_t WS_H = 359 * MiB;
constexpr size_t WS_END = 491 * MiB;

constexpr int LDS_BYTES = 147456;
constexpr int NWAVES = 8, NTHREADS = 512;

__device__ __forceinline__ unsigned cvt_pk_bf16(float lo, float hi) { unsigned r; asm volatile("v_cvt_pk_bf16_f32 %0, %1, %2" : "=v"(r) : "v"(lo), "v"(hi)); return r; }
__device__ __forceinline__ unsigned short f2bf(float f) { return (unsigned short)(cvt_pk_bf16(f, 0.f) & 0xffffu); }
__device__ __forceinline__ float bf2f(unsigned short b) { return __uint_as_float(((unsigned)b) << 16); }
__device__ __forceinline__ float fast_exp2(float x) { return __builtin_amdgcn_exp2f(x); }
__device__ __forceinline__ float fast_rcp(float x) { return __builtin_amdgcn_rcpf(x); }
__device__ __forceinline__ float sigmoidf_(float x) { return fast_rcp(1.0f + fast_exp2(-x * LOG2E)); }
__device__ __forceinline__ float gelu_tanh(float x) { const float z = 0.7978845608028654f * (x + 0.044715f * x * x * x); return x * fast_rcp(1.0f + fast_exp2(-2.0f * LOG2E * z)); }
__device__ __forceinline__ int crow(int reg, int h) { return (reg & 3) + 8 * (reg >> 2) + 4 * h; }
__device__ __forceinline__ float wave_sum(float v) {
#pragma unroll
    for (int o = 1; o < 64; o <<= 1) v += __shfl_xor(v, o);
    return v;
}
#define MFMA32(a, b, c) __builtin_amdgcn_mfma_f32_32x32x16_bf16((a), (b), (c), 0, 0, 0)

namespace pg8 {
constexpr int BM = 256, BK = 64, HALF = 128, HTB = HALF * BK * 2, STAGE_BYTES = 8 * HTB, NXCD = 8, WGM = 8;
__host__ __device__ __forceinline__ int lds_byte(int r, int c) { const int st = (r >> 4) * 2 + (c >> 5), rr = r & 15, cc = c & 31, ob = rr * 64 + cc * 2; return st * 1024 + (ob ^ (((ob >> 9) & 1) << 5)); }
__host__ __device__ __forceinline__ void stage_rc(int b, int& R, int& C) { const int st = b / 1024, sb = b % 1024, swz = sb ^ (((sb >> 9) & 1) << 5); R = (st >> 1) * 16 + swz / 64; C = (st & 1) * 32 + (swz % 64) / 2; }
__host__ __device__ __forceinline__ int perm32(int rho) { const int n = rho >> 4, i = rho & 15; return 8 * (i >> 2) + 4 * n + (i & 3); }

struct Unit { int pm, pn; };
struct Gemm { const bf16_t* A; const bf16_t* Bt; int M, N, K; };

struct StaticOrder {
    int nM, nN, nwg, G, c;
    __host__ __device__ void init(int M, int N, int G_, int c_) { nM = M / BM; nN = N / BM; nwg = nM * nN; G = G_; c = c_; }
    __host__ __device__ bool next(int i, Unit& u) const {
        const long L = (long)i * G + c; if (L >= nwg) return false;
        int wgid = (int)L; { const int q = nwg / NXCD, r = nwg % NXCD, xcd = wgid % NXCD, off = wgid / NXCD; wgid = (xcd < r ? xcd * (q + 1) : r * (q + 1) + (xcd - r) * q) + off; }
        const int nig = WGM * nN, gid = wgid / nig, fm = gid * WGM, gsz = (nM - fm) < WGM ? (nM - fm) : WGM;
        u.pm = fm + ((wgid % nig) % gsz); u.pn = (wgid % nig) / gsz; return true;
    }
    __device__ __forceinline__ void a_ready(const Unit&) const {}
    __device__ __forceinline__ void done(const Unit&) const {}
};

template <class Epi, class Sched, bool ALIGN_EPI = false, bool SP2 = false>
__device__ __forceinline__ void gemm_phase(LAS unsigned char* lds, const Gemm g, const Sched& S, const Epi& E) {
    const int tid = threadIdx.x, wid = __builtin_amdgcn_readfirstlane(tid >> 6), lane = tid & 63, wr = wid >> 2, wc = wid & 3, fr = lane & 15, fq = lane >> 4;
    const int K = g.K, nt = K / BK;
    unsigned voffA[2], voffB[2];
#pragma unroll
    for (int i = 0; i < 2; ++i) { int R, C; stage_rc(tid * 16 + i * 8192, R, C); const int Rb = Epi::PERM ? ((R & ~31) + perm32(R & 31)) : R;
        voffA[i] = (unsigned)(R * K + C) * 2u; voffB[i] = (unsigned)(Rb * K + C) * 2u; }
    const size_t kstep = (size_t)(BK * 2);
    const size_t hstep = (size_t)HALF * K * 2;
    const size_t tstep = 2 * hstep;
    const unsigned ldsw = (unsigned)wid * 1024u;
    const int aoff = lds_byte(wr * 64 + fr, fq * 8), boff = lds_byte(wc * 32 + fr, fq * 8);
#define PG8_SA(b, h) (((b) * 2 + (h)) * HTB)
#define PG8_SB(b, h) ((4 + (b) * 2 + (h)) * HTB)
#define PG8_STAGE(bufoff, gbase, voff) do { _Pragma("unroll") for (int _i = 0; _i < 2; ++_i) \
        __builtin_amdgcn_global_load_lds((const unsigned*)((const char*)(gbase) + (voff)[_i]), (LAS unsigned*)(lds + (bufoff) + ldsw + _i * 8192), 16, 0, 0); } while (0)
#define PG8_LDA(dst, b, h) do { _Pragma("unroll") for (int m = 0; m < 4; ++m) _Pragma("unroll") for (int k = 0; k < 2; ++k) dst[m][k] = *(const LAS bf16x8*)(lds + PG8_SA(b, h) + aoff + m * 2048 + k * 1024); } while (0)
#define PG8_LDB(dst, b, h) do { _Pragma("unroll") for (int n = 0; n < 2; ++n) _Pragma("unroll") for (int k = 0; k < 2; ++k) dst[n][k] = *(const LAS bf16x8*)(lds + PG8_SB(b, h) + boff + n * 2048 + k * 1024); } while (0)
#define PG8_MMA(ai, bj, At, Bt) do { __builtin_amdgcn_s_setprio(1); _Pragma("unroll") for (int m = 0; m < 4; ++m) _Pragma("unroll") for (int n = 0; n < 2; ++n) _Pragma("unroll") for (int k = 0; k < 2; ++k) \
        acc[ai][bj][m][n] = __builtin_amdgcn_mfma_f32_16x16x32_bf16(Bt[n][k], At[m][k], acc[ai][bj][m][n], 0, 0, 0); __builtin_amdgcn_s_setprio(0); } while (0)
#define PG8_WAIT_V(n) asm volatile("s_waitcnt vmcnt(" #n ")" ::: "memory")
#define PG8_WAIT_L(n) asm volatile("s_waitcnt lgkmcnt(" #n ")" ::: "memory")
#define PG8_BAR __builtin_amdgcn_s_barrier()
#define PG8_SCHED __builtin_amdgcn_sched_barrier(0)
    Unit cur, nxt; int ui = 0;
    if (!S.next(0, cur)) return;
    f32x4 acc[2][2][4][2];
#pragma unroll
    for (int a = 0; a < 2; ++a)
#pragma unroll
        for (int b = 0; b < 2; ++b)
#pragma unroll
            for (int m = 0; m < 4; ++m)
#pragma unroll
                for (int n = 0; n < 2; ++n) acc[a][b][m][n] = (f32x4){0.f, 0.f, 0.f, 0.f};
    bf16x8 At[4][2], B0[2][2], B1[2][2];
    const char* cA = (const char*)g.A + (size_t)cur.pm * tstep; const char* cB = (const char*)g.Bt + (size_t)cur.pn * tstep;
    S.a_ready(cur);
    if constexpr (SP2) {
        PG8_STAGE(PG8_SB(0, 0), cB, voffB); PG8_STAGE(PG8_SB(0, 1), cB + hstep, voffB); PG8_STAGE(PG8_SA(0, 0), cA, voffA); PG8_STAGE(PG8_SA(0, 1), cA + hstep, voffA);
        if (wr == 1) PG8_BAR;
        PG8_WAIT_V(2); PG8_BAR;
        PG8_STAGE(PG8_SB(1, 0), cB + kstep, voffB); PG8_STAGE(PG8_SA(1, 0), cA + kstep, voffA); PG8_STAGE(PG8_SB(1, 1), cB + hstep + kstep, voffB);
        PG8_WAIT_V(6); PG8_BAR;
    } else {
        PG8_STAGE(PG8_SB(0, 0), cB, voffB); PG8_STAGE(PG8_SA(0, 0), cA, voffA); PG8_STAGE(PG8_SB(0, 1), cB + hstep, voffB); PG8_STAGE(PG8_SA(0, 1), cA + hstep, voffA);
        if (wr == 1) PG8_BAR;
        PG8_WAIT_V(4); PG8_BAR;
        PG8_STAGE(PG8_SB(1, 0), cB + kstep, voffB); PG8_STAGE(PG8_SA(1, 0), cA + kstep, voffA); PG8_STAGE(PG8_SB(1, 1), cB + hstep + kstep, voffB);
        PG8_WAIT_V(6); PG8_BAR;
    }
    for (;;) {
        const bool has_next = S.next(ui + 1, nxt);
        const char* nA = has_next ? (const char*)g.A + (size_t)nxt.pm * tstep : cA; const char* nB = has_next ? (const char*)g.Bt + (size_t)nxt.pn * tstep : cB;
        for (int t = 0; t < nt; t += 2) {
            const bool last = (t == nt - 2);
            const char* a1 = cA + (size_t)(t + 1) * kstep;
            const char* a2 = last ? nA : cA + (size_t)(t + 2) * kstep; const char* b2 = last ? nB : cB + (size_t)(t + 2) * kstep;
            const char* a3 = a2 + kstep; const char* b3 = b2 + kstep;
            if (last && has_next) S.a_ready(nxt);
            if constexpr (SP2) {
            PG8_LDB(B0, 0, 0); PG8_LDB(B1, 0, 1); PG8_SCHED; PG8_LDA(At, 0, 0); PG8_STAGE(PG8_SA(1, 1), a1 + hstep, voffA);
            PG8_WAIT_V(8); PG8_WAIT_L(0); PG8_BAR; PG8_MMA(0, 0, At, B0); PG8_MMA(0, 1, At, B1); PG8_BAR; PG8_SCHED;
            PG8_LDA(At, 0, 1); PG8_STAGE(PG8_SB(0, 0), b2, voffB); PG8_STAGE(PG8_SB(0, 1), b2 + hstep, voffB); PG8_STAGE(PG8_SA(0, 0), a2, voffA);
            PG8_WAIT_V(8); PG8_WAIT_L(0); PG8_BAR; PG8_MMA(1, 0, At, B0); PG8_MMA(1, 1, At, B1); PG8_BAR; PG8_SCHED;
            PG8_LDB(B0, 1, 0); PG8_LDB(B1, 1, 1); PG8_SCHED; PG8_LDA(At, 1, 0); PG8_STAGE(PG8_SA(0, 1), a2 + hstep, voffA);
            PG8_WAIT_V(8); PG8_WAIT_L(0); PG8_BAR; PG8_MMA(0, 0, At, B0); PG8_MMA(0, 1, At, B1); PG8_BAR; PG8_SCHED;
            PG8_LDA(At, 1, 1); PG8_STAGE(PG8_SB(1, 0), b3, voffB); PG8_STAGE(PG8_SB(1, 1), b3 + hstep, voffB); PG8_STAGE(PG8_SA(1, 0), a3, voffA);
            PG8_WAIT_V(8); PG8_WAIT_L(0); PG8_BAR; PG8_MMA(1, 0, At, B0); PG8_MMA(1, 1, At, B1); PG8_BAR; PG8_SCHED;
            } else {
            PG8_LDB(B0, 0, 0); PG8_SCHED; PG8_LDA(At, 0, 0); PG8_STAGE(PG8_SA(1, 1), a1 + hstep, voffA);
            PG8_WAIT_L(8); PG8_BAR; PG8_WAIT_L(0); PG8_MMA(0, 0, At, B0); PG8_BAR; PG8_SCHED;
            PG8_LDB(B1, 0, 1); PG8_STAGE(PG8_SB(0, 0), b2, voffB);
            PG8_BAR; PG8_WAIT_L(0); PG8_MMA(0, 1, At, B1); PG8_BAR;
            PG8_LDA(At, 0, 1); PG8_STAGE(PG8_SA(0, 0), a2, voffA);
            PG8_BAR; PG8_WAIT_L(0); PG8_MMA(1, 0, At, B0); PG8_BAR; PG8_SCHED;
            PG8_STAGE(PG8_SB(0, 1), b2 + hstep, voffB);
            PG8_WAIT_V(6); PG8_BAR; PG8_MMA(1, 1, At, B1); PG8_BAR;
            PG8_LDB(B0, 1, 0); PG8_SCHED; PG8_LDA(At, 1, 0); PG8_STAGE(PG8_SA(0, 1), a2 + hstep, voffA);
            PG8_WAIT_L(8); PG8_BAR; PG8_WAIT_L(0); PG8_MMA(0, 0, At, B0); PG8_BAR; PG8_SCHED;
            PG8_LDB(B1, 1, 1); PG8_STAGE(PG8_SB(1, 0), b3, voffB);
            PG8_BAR; PG8_WAIT_L(0); PG8_MMA(0, 1, At, B1); PG8_BAR;
            PG8_LDA(At, 1, 1); PG8_STAGE(PG8_SA(1, 0), a3, voffA);
            PG8_BAR; PG8_WAIT_L(0); PG8_MMA(1, 0, At, B0); PG8_BAR; PG8_SCHED;
            PG8_STAGE(PG8_SB(1, 1), b3 + hstep, voffB);
            PG8_WAIT_V(6); PG8_BAR; PG8_MMA(1, 1, At, B1); PG8_BAR;
            }
        }
        if constexpr (ALIGN_EPI) { if (wr == 0) PG8_BAR; }
        E(acc, cur, wr, wc, fr, fq); S.done(cur);
        if (!has_next) break;
#pragma unroll
        for (int a = 0; a < 2; ++a)
#pragma unroll
            for (int b = 0; b < 2; ++b)
#pragma unroll
                for (int m = 0; m < 4; ++m)
#pragma unroll
                    for (int n = 0; n < 2; ++n) acc[a][b][m][n] = (f32x4){0.f, 0.f, 0.f, 0.f};
        cur = nxt; cA = nA; cB = nB; ++ui;
        if constexpr (ALIGN_EPI) { if (wr == 1) PG8_BAR; }
    }
    PG8_WAIT_V(0);
    if constexpr (!ALIGN_EPI) { if (wr == 0) PG8_BAR; }
    PG8_BAR;
#undef PG8_SA
#undef PG8_SB
#undef PG8_STAGE
#undef PG8_LDA
#undef PG8_LDB
#undef PG8_MMA
#undef PG8_WAIT_V
#undef PG8_WAIT_L
#undef PG8_BAR
#undef PG8_SCHED
}
}

struct EpiIn {
    static constexpr bool PERM = false;
    bf16_t* QP; bf16_t* KP; bf16_t* VP; bf16_t* QS; float* XBR; bf16_t* GB; float* out; const float* rope;
    __device__ __forceinline__ void operator()(const f32x4 (&acc)[2][2][4][2], const pg8::Unit& u, int wr, int wc, int fr, int fq) const {
        const int type = u.pn >> 2, tl = u.pn & 3; const bool samp = (u.pm == 32);
        if (type <= 1) {
            const int head = 2 * tl + (wc >> 1), comp = wc & 1;
#pragma unroll
            for (int ai = 0; ai < 2; ++ai)
#pragma unroll
                for (int m = 0; m < 4; ++m) {
                    const int r = u.pm * 256 + ai * 128 + wr * 64 + m * 16 + fr;
                    int b, t, ridx; if (!samp) { b = r >> 12; t = r & 4095; ridx = t; } else { const int rs = r - MP; b = rs >> 4; t = rs & 15; ridx = 4096 + t; }
#pragma unroll
                    for (int n = 0; n < 2; ++n) {
                        const int d = 16 * n + 4 * fq;
                        const f32x4 cs = *(const f32x4*)(rope + (size_t)ridx * 64 + d), sn = *(const f32x4*)(rope + (size_t)ridx * 64 + 32 + d);
                        const f32x4 x1 = acc[ai][0][m][n], x2 = acc[ai][1][m][n];
                        f32x4 o1 = x1 * cs - x2 * sn, o2 = x2 * cs + x1 * sn;
                        if (type == 0) {
                            o1 = o1 * QSCALE; o2 = o2 * QSCALE;
                            bf16_t* dst = samp ? QS + ((size_t)(((b * 8 + head) * 2 + comp) * 16 + t)) * 64 + d : QP + ((size_t)(((b * 8 + head) * 2 + comp) * 4096 + t)) * 64 + d;
                            *(u32x2*)dst = (u32x2){cvt_pk_bf16(o1[0], o1[1]), cvt_pk_bf16(o1[2], o1[3])};
                            *(u32x2*)(dst + 32) = (u32x2){cvt_pk_bf16(o2[0], o2[1]), cvt_pk_bf16(o2[2], o2[3])};
                        } else {
                            float* ko = out + (samp ? O_KS + (size_t)(r - MP) * 1024 : O_KP + (size_t)r * 1024) + head * 128 + comp * 64 + d;
                            *(f32x4*)ko = o1; *(f32x4*)(ko + 32) = o2;
                            if (!samp) { bf16_t* dst = KP + ((size_t)(((b * 8 + head) * 2 + comp) * 4096 + t)) * 64 + d;
                                *(u32x2*)dst = (u32x2){cvt_pk_bf16(o1[0], o1[1]), cvt_pk_bf16(o1[2], o1[3])};
                                *(u32x2*)(dst + 32) = (u32x2){cvt_pk_bf16(o2[0], o2[1]), cvt_pk_bf16(o2[2], o2[3])}; }
                        }
                    }
                }
        } else {
#pragma unroll
            for (int ai = 0; ai < 2; ++ai)
#pragma unroll
                for (int m = 0; m < 4; ++m) {
                    const int r = u.pm * 256 + ai * 128 + wr * 64 + m * 16 + fr;
#pragma unroll
                    for (int bj = 0; bj < 2; ++bj)
#pragma unroll
                        for (int n = 0; n < 2; ++n) {
                            const int col = 256 * tl + 128 * bj + 32 * wc + 16 * n + 4 * fq;
                            const f32x4 v = acc[ai][bj][m][n];
                            if (type == 2) {
                                float* vo = out + (samp ? O_VS + (size_t)(r - MP) * 1024 : O_VP + (size_t)r * 1024) + col;
                                *(f32x4*)vo = v;
                                if (!samp) { const int b = r >> 12, t = r & 4095; bf16_t* dst = VP + ((size_t)((b * 8 + (col >> 7)) * 4096 + t)) * 128 + (col & 127);
                                    *(u32x2*)dst = (u32x2){cvt_pk_bf16(v[0], v[1]), cvt_pk_bf16(v[2], v[3])}; }
                            } else if (type == 3) {
                                *(f32x4*)(XBR + (size_t)r * 1024 + col) = v;
                            } else {
                                *(u32x2*)(GB + (size_t)r * 1024 + col) = (u32x2){cvt_pk_bf16(gelu_tanh(v[0]), gelu_tanh(v[1])), cvt_pk_bf16(gelu_tanh(v[2]), gelu_tanh(v[3]))};
                            }
                        }
                }
        }
    }
};
struct EpiAxpy {
    static constexpr bool PERM = false;
    const float* base_p; const float* base_s; float* outp;
    __device__ __forceinline__ void operator()(const f32x4 (&acc)[2][2][4][2], const pg8::Unit& u, int wr, int wc, int fr, int fq) const {
        const int row0 = u.pm * 256 + wr * 64 + fr, col0 = u.pn * 256 + wc * 32 + 4 * fq;
        const float* bs = (u.pm == 32) ? base_s - (size_t)MP * DM : base_p;
#pragma unroll
        for (int ai = 0; ai < 2; ++ai)
#pragma unroll
            for (int m = 0; m < 4; ++m) { const size_t off = (size_t)(row0 + ai * 128 + m * 16) * DM + col0;
#pragma unroll
                for (int bj = 0; bj < 2; ++bj)
#pragma unroll
                    for (int n = 0; n < 2; ++n) { const f32x4 b = *(const f32x4*)(bs + off + bj * 128 + n * 16); *(f32x4*)(outp + off + bj * 128 + n * 16) = b * DN_ALPHA + acc[ai][bj][m][n]; }
                if (m & 1) asm volatile("" ::: "memory"); }
    }
};
struct EpiUp {
    static constexpr bool PERM = true;
    bf16_t* H;
    __device__ __forceinline__ void operator()(const f32x4 (&acc)[2][2][4][2], const pg8::Unit& u, int wr, int wc, int fr, int fq) const {
        const int row0 = u.pm * 256 + wr * 64 + fr, col0 = u.pn * 256 + wc * 32 + 8 * fq;
#pragma unroll
        for (int ai = 0; ai < 2; ++ai)
#pragma unroll
            for (int m = 0; m < 4; ++m) { bf16_t* rowp = H + (size_t)(row0 + ai * 128 + m * 16) * DFF + col0;
#pragma unroll
                for (int bj = 0; bj < 2; ++bj) { f32x4 v0 = acc[ai][bj][m][0], v1 = acc[ai][bj][m][1];
#pragma unroll
                    for (int j = 0; j < 4; ++j) { const float a = fmaxf(v0[j], 0.f), b = fmaxf(v1[j], 0.f); v0[j] = a * a; v1[j] = b * b; }
                    u32x4 w; w.x = cvt_pk_bf16(v0[0], v0[1]); w.y = cvt_pk_bf16(v0[2], v0[3]); w.z = cvt_pk_bf16(v1[0], v1[1]); w.w = cvt_pk_bf16(v1[2], v1[3]);
                    *(u32x4*)(rowp + bj * 128) = w; } }
    }
};

struct Args { const float* in[26]; float* out; unsigned char* ws; int ph_lo, ph_hi; };
struct Ctx {
    LAS unsigned char* lds; int tid, lane, wave, G, bid;
    const float* const* in; float* out; unsigned char* ws;
};

__device__ __forceinline__ void p0_transpose_item(const float* W, int K, int N, bf16_t* WT, LAS float* scr, int item, int lane, bool ropeperm) {
    const int nblk = N / 32, kb = item / nblk, nb = item % nblk, k0 = 64 * kb, n0 = 32 * nb;
#pragma unroll 8
    for (int i = 0; i < 32; ++i) { const int kk = 2 * i + (lane >> 5); scr[kk * 33 + (lane & 31)] = W[(size_t)(k0 + kk) * N + n0 + (lane & 31)]; }
    asm volatile("s_waitcnt lgkmcnt(0)" ::: "memory");
    int d0 = n0;
    if (ropeperm && n0 < 2048) { const int tile = n0 >> 8, c = n0 & 255, g = c >> 6, bj = (c >> 5) & 1; d0 = tile * 256 + 128 * bj + 32 * g; }
    const int c = lane & 7;
#pragma unroll
    for (int j = 0; j < 4; ++j) { const int n = (lane >> 3) + 8 * j; const LAS float* s = scr + (8 * c) * 33 + n;
        u32x4 o; o.x = cvt_pk_bf16(s[0 * 33], s[1 * 33]); o.y = cvt_pk_bf16(s[2 * 33], s[3 * 33]); o.z = cvt_pk_bf16(s[4 * 33], s[5 * 33]); o.w = cvt_pk_bf16(s[6 * 33], s[7 * 33]);
        *(u32x4*)(WT + (size_t)(d0 + n) * K + k0 + 8 * c) = o; }
    asm volatile("s_waitcnt lgkmcnt(0)" ::: "memory");
}
__device__ __forceinline__ void p0_prologue(const Ctx& C) {
    LAS float* scr = (LAS float*)(C.lds + C.wave * 16384);
    const int gw = C.bid * NWAVES + C.wave, NGW = C.G * NWAVES;
    constexpr int I_IN = (DM / 64) * (INC / 32), I_OUT = (DM / 64) * (DM / 32), I_UP = (DM / 64) * (DFF / 32), I_DN = (DFF / 64) * (DM / 32);
    constexpr int NITEMS = I_IN + I_OUT + I_UP + I_DN;
    for (int it = gw; it < NITEMS; it += NGW) {
        int r = it;
        if (r < I_IN) { p0_transpose_item(C.in[6], DM, INC, (bf16_t*)(C.ws + WS_WIN), scr, r, C.lane, true); continue; } r -= I_IN;
        if (r < I_OUT) { p0_transpose_item(C.in[19], DM, DM, (bf16_t*)(C.ws + WS_WOUT), scr, r, C.lane, false); continue; } r -= I_OUT;
        if (r < I_UP) { p0_transpose_item(C.in[22], DM, DFF, (bf16_t*)(C.ws + WS_WUP), scr, r, C.lane, false); continue; } r -= I_UP;
        p0_transpose_item(C.in[23], DFF, DM, (bf16_t*)(C.ws + WS_WDOWN), scr, r, C.lane, false);
    }
    { const size_t nth = (size_t)C.G * NTHREADS; bf16_t* XB = (bf16_t*)(C.ws + WS_XB);
      for (size_t i = (size_t)C.bid * NTHREADS + C.tid; i < (size_t)MT * DM / 8; i += nth) {
          const size_t e = i * 8; const float* src = (e < (size_t)MP * DM) ? C.in[0] + e : C.in[1] + (e - (size_t)MP * DM);
          const f32x4 a = *(const f32x4*)src, b = *(const f32x4*)(src + 4);
          u32x4 o; o.x = cvt_pk_bf16(a[0], a[1]); o.y = cvt_pk_bf16(a[2], a[3]); o.z = cvt_pk_bf16(b[0], b[1]); o.w = cvt_pk_bf16(b[2], b[3]);
          *(u32x4*)(XB + e) = o; } }
    { float* rope = (float*)(C.ws + WS_ROPE);
      for (int i = C.bid * NTHREADS + C.tid; i < 4112 * 32; i += C.G * NTHREADS) {
          const int ridx = i >> 5, k = i & 31; const int pos = ridx < 4096 ? ridx : PAST + (ridx - 4096);
          const float inv = exp2f(-(float)k * (13.287712379549449f / 32.0f));
          const float ang = (float)pos * inv;
          double rev = (double)ang * 0.15915494309189535; rev -= rint(rev);
          const float rf = (float)rev;
          rope[(size_t)ridx * 64 + k] = __builtin_amdgcn_cosf(rf); rope[(size_t)ridx * 64 + 32 + k] = __builtin_amdgcn_sinf(rf); } }
}

constexpr int AT_STAGE = 32768, AT_WSF = 65536, AT_EXCH = 0, AT_OST = 66560;
__device__ __forceinline__ s16x4 vtr(const LAS unsigned char* p) { typedef short v4i16_t __attribute__((ext_vector_type(4))); return __builtin_bit_cast(s16x4, __builtin_amdgcn_ds_read_tr16_b64_v4i16((LAS v4i16_t*)p)); }
__device__ __forceinline__ bf16x8 pack8(const f32x16& x, int s) {
    u32x4 p; p.x = cvt_pk_bf16(x[8 * s], x[8 * s + 1]); p.y = cvt_pk_bf16(x[8 * s + 2], x[8 * s + 3]); p.z = cvt_pk_bf16(x[8 * s + 4], x[8 * s + 5]); p.w = cvt_pk_bf16(x[8 * s + 6], x[8 * s + 7]);
    return __builtin_bit_cast(bf16x8, p);
}
__device__ __forceinline__ float max16(const f32x16& a) { float m = fmaxf(a[0], a[1]);
#pragma unroll
    for (int i = 2; i < 16; ++i) m = fmaxf(m, a[i]); return m; }

__device__ __forceinline__ void attn_prompt_unit(const Ctx& C, int b, int h, int qi, float lam) {
    LAS unsigned char* lds = C.lds; int lane_ = C.lane, w_ = C.wave; asm volatile("" : "+v"(lane_)); asm volatile("" : "+s"(w_));
    const int lane = lane_, w = w_, r = lane & 31, hh = lane >> 5;
    const int comp = w >> 2, rg = w & 3;
    const bf16_t* QP = (const bf16_t*)(C.ws + WS_QP); const bf16_t* KP = (const bf16_t*)(C.ws + WS_KP); const bf16_t* VP = (const bf16_t*)(C.ws + WS_VP);
    const int NT = 2 * qi + 2, my_nt = 2 * qi + 1 + (rg >> 1);
    bf16x8 qf[4];
    { const bf16_t* qs = QP + ((size_t)(((b * 8 + h) * 2 + comp) * 4096 + 128 * qi + 32 * rg + r)) * 64 + 8 * hh;
#pragma unroll
      for (int s = 0; s < 4; ++s) qf[s] = *(const bf16x8*)(qs + 16 * s); }
    const int krow_ = 8 * w + (lane >> 3), kcp = lane & 7, klc = kcp ^ ((krow_ >> 1) & 7);
    const bf16_t* k1src = KP + ((size_t)(((b * 8 + h) * 2 + 0) * 4096 + krow_)) * 64 + klc * 8;
    const bf16_t* k2src = KP + ((size_t)(((b * 8 + h) * 2 + 1) * 4096 + krow_)) * 64 + klc * 8;
    const bf16_t* vsrc0; const bf16_t* vsrc1;
    { const int q0 = 2 * w, q1 = 2 * w + 1;
      vsrc0 = VP + ((size_t)((b * 8 + h) * 4096 + 16 * (q0 & 3) + (lane >> 2))) * 128 + (q0 >> 2) * 32 + (lane & 3) * 8;
      vsrc1 = VP + ((size_t)((b * 8 + h) * 4096 + 16 * (q1 & 3) + (lane >> 2))) * 128 + (q1 >> 2) * 32 + (lane & 3) * 8; }
    const unsigned wl = (unsigned)w * 1024u;
#define AT_ISSUE(jt, st) do { \
        __builtin_amdgcn_global_load_lds((const unsigned*)(k1src + (size_t)(jt) * 64 * 64), (LAS unsigned*)(lds + (st) * AT_STAGE + wl), 16, 0, 0); \
        __builtin_amdgcn_global_load_lds((const unsigned*)(k2src + (size_t)(jt) * 64 * 64), (LAS unsigned*)(lds + (st) * AT_STAGE + 8192 + wl), 16, 0, 0); \
        __builtin_amdgcn_global_load_lds((const unsigned*)(vsrc0 + (size_t)(jt) * 64 * 128), (LAS unsigned*)(lds + (st) * AT_STAGE + 16384 + 2 * wl), 16, 0, 0); \
        __builtin_amdgcn_global_load_lds((const unsigned*)(vsrc1 + (size_t)(jt) * 64 * 128), (LAS unsigned*)(lds + (st) * AT_STAGE + 16384 + 2 * wl + 1024), 16, 0, 0); } while (0)
    LAS float* wsf = (LAS float*)(lds + AT_WSF) + w * 32;
    f32x16 o[4];
#pragma unroll
    for (int d = 0; d < 4; ++d)
#pragma unroll
        for (int i = 0; i < 16; ++i) o[d][i] = 0.f;
    float m_run = -1e30f, l_run = 0.f;
    const int kro = r * 128, ksw = (r >> 1) & 7;
    const int i16 = lane & 15, blk = (lane >> 4) & 1;
    const int vro = (4 * hh + (i16 >> 2)) * 64 + 32 * blk + 8 * (i16 & 3);
    AT_ISSUE(0, 0);
    for (int jt = 0; jt < NT; ++jt) {
        const int st = jt & 1;
        if (jt + 1 < NT) { AT_ISSUE(jt + 1, st ^ 1); asm volatile("s_waitcnt vmcnt(4)" ::: "memory"); }
        else asm volatile("s_waitcnt vmcnt(0)" ::: "memory");
        __builtin_amdgcn_s_barrier();
        asm volatile("" ::: "memory");
        if (jt < my_nt) {
            const LAS unsigned char* kb = lds + st * AT_STAGE + comp * 8192 + kro;
            const LAS unsigned char* vb = lds + st * AT_STAGE + 16384 + vro;
            f32x16 s0, s1;
#pragma unroll
            for (int i = 0; i < 16; ++i) { s0[i] = 0.f; s1[i] = 0.f; }
#pragma unroll
            for (int s = 0; s < 4; ++s) {
                const int co = ((2 * s + hh) ^ ksw) * 16;
                const bf16x8 k0 = *(const LAS bf16x8*)(kb + co), k1 = *(const LAS bf16x8*)(kb + 32 * 128 + co);
                s0 = MFMA32(k0, qf[s], s0); s1 = MFMA32(k1, qf[s], s1);
            }
            float mx = fmaxf(max16(s0), max16(s1));
            mx = fmaxf(mx, __shfl_xor(mx, 32));
            const float mnew = fmaxf(m_run, mx), alpha = fast_exp2(m_run - mnew);
            m_run = mnew;
            float ls = 0.f;
#pragma unroll
            for (int i = 0; i < 16; ++i) { s0[i] = fast_exp2(s0[i] - mnew); s1[i] = fast_exp2(s1[i] - mnew); ls += s0[i] + s1[i]; }
            l_run = l_run * alpha + ls;
            if (hh == 0) wsf[r] = alpha;
            asm volatile("s_waitcnt lgkmcnt(0)" ::: "memory");
#pragma unroll
            for (int i = 0; i < 16; ++i) { const float a = wsf[crow(i, hh)];
#pragma unroll
                for (int d = 0; d < 4; ++d) o[d][i] *= a; }
            bf16x8 pa[4]; pa[0] = pack8(s0, 0); pa[1] = pack8(s0, 1); pa[2] = pack8(s1, 0); pa[3] = pack8(s1, 1);
#pragma unroll
            for (int ks = 0; ks < 4; ++ks) {
#pragma unroll
                for (int d = 0; d < 4; ++d) {
                    const s16x4 lo = vtr(vb + d * 4096 + ks * 1024), hi = vtr(vb + d * 4096 + ks * 1024 + 512);
                    const bf16x8 vf = __builtin_shufflevector(lo, hi, 0, 1, 2, 3, 4, 5, 6, 7);
                    o[d] = MFMA32(pa[ks], vf, o[d]);
                }
            }
        }
        asm volatile("s_waitcnt lgkmcnt(0)" ::: "memory");
        __builtin_amdgcn_s_barrier();
        asm volatile("" ::: "memory");
    }
#undef AT_ISSUE
    { float lt = l_run + __shfl_xor(l_run, 32); const float inv = fast_rcp(lt) * (comp ? lam : 1.0f);
      if (hh == 0) wsf[r] = inv;
      asm volatile("s_waitcnt lgkmcnt(0)" ::: "memory");
      float iv[16];
#pragma unroll
      for (int i = 0; i < 16; ++i) iv[i] = wsf[crow(i, hh)];
      LAS float* ex = (LAS float*)(lds + AT_EXCH) + rg * 4096;
      if (comp == 1) {
#pragma unroll
          for (int d = 0; d < 4; ++d)
#pragma unroll
              for (int i = 0; i < 16; ++i) ex[crow(i, hh) * 128 + d * 32 + r] = o[d][i] * iv[i];
      }
      asm volatile("s_waitcnt lgkmcnt(0)" ::: "memory");
      __builtin_amdgcn_s_barrier();
      asm volatile("" ::: "memory");
      if (comp == 0) {
          const float* sg = C.in[11]; float gsc[4];
#pragma unroll
          for (int d = 0; d < 4; ++d) gsc[d] = sg[d * 32 + r] * (1.0f - LAM_INIT);
          LAS unsigned short* ost = (LAS unsigned short*)(lds + AT_OST) + rg * 4096;
#pragma unroll
          for (int i = 0; i < 16; ++i) { const int q = crow(i, hh); float v[4], ss = 0.f;
#pragma unroll
              for (int d = 0; d < 4; ++d) { v[d] = o[d][i] * iv[i] - ex[q * 128 + d * 32 + r]; ss += v[d] * v[d]; }
              ss += __shfl_xor(ss, 1); ss += __shfl_xor(ss, 2); ss += __shfl_xor(ss, 4); ss += __shfl_xor(ss, 8); ss += __shfl_xor(ss, 16);
              const float rstd = rsqrtf(ss * (1.0f / 128.0f) + RMS_EPS);
#pragma unroll
              for (int d = 0; d < 4; ++d) ost[q * 128 + d * 32 + r] = f2bf(v[d] * rstd * gsc[d]); }
          asm volatile("s_waitcnt lgkmcnt(0)" ::: "memory");
          bf16_t* cat = (bf16_t*)(C.ws + WS_CAT) + ((size_t)(b * 4096 + 128 * qi + 32 * rg + (lane >> 4))) * DM + h * 128 + (lane & 15) * 8;
#pragma unroll
          for (int k = 0; k < 8; ++k) *(u32x4*)(cat + (size_t)(4 * k) * DM) = *(const LAS u32x4*)(ost + ((lane >> 4) + 4 * k) * 128 + (lane & 15) * 8);
      }
      asm volatile("s_waitcnt lgkmcnt(0)" ::: "memory");
      __builtin_amdgcn_s_barrier();
      asm volatile("" ::: "memory");
    }
}

constexpr int SA_O = 0, SA_ML = 131072, SA_WSF = 131072 + 2048, SA_QH = 131072 + 4096;
__device__ __forceinline__ void attn_sample_unit(const Ctx& C, int b, int h, float lam) {
    LAS unsigned char* lds = C.lds; int lane_ = C.lane, w_ = C.wave; asm volatile("" : "+v"(lane_)); asm volatile("" : "+s"(w_));
    const int lane = lane_, w = w_, r = lane & 31, hh = lane >> 5;
    const bf16_t* QS = (const bf16_t*)(C.ws + WS_QS);
    { const int s = w; bf16x8 q;
#pragma unroll
      for (int j = 0; j < 8; ++j) q[j] = 0;
      const int cq = (s < 4) ? 0 : 1; const bool act = cq ? (r >= 16) : (r < 16);
      if (act) q = *(const bf16x8*)(QS + ((size_t)(((b * 8 + h) * 2 + cq) * 16 + (r & 15))) * 64 + 16 * (s & 3) + 8 * hh);
      *(LAS bf16x8*)(lds + SA_QH + s * 1024 + lane * 16) = q; }
    asm volatile("s_waitcnt lgkmcnt(0)" ::: "memory");
    __builtin_amdgcn_s_barrier();
    asm volatile("" ::: "memory");
    LAS float* wsf = (LAS float*)(lds + SA_WSF) + w * 32;
    f32x16 o[4];
#pragma unroll
    for (int d = 0; d < 4; ++d)
#pragma unroll
        for (int i = 0; i < 16; ++i) o[d][i] = 0.f;
    float m_run = -1e30f, l_run = 0.f;
    const float* ck = C.in[2] + (size_t)b * PAST * 1024 + h * 128; const float* cv = C.in[3] + (size_t)b * PAST * 1024 + h * 128;
    const float* nk = C.out + O_KS + (size_t)b * 16 * 1024 + h * 128; const float* nv = C.out + O_VS + (size_t)b * 16 * 1024 + h * 128;
#pragma unroll 1
    for (int tile = w; tile < 65; tile += 8) {
        const bool isnew = (tile == 64);
        const float* kbase = isnew ? nk : ck + (size_t)tile * 32 * 1024; const float* vbase = isnew ? nv : cv + (size_t)tile * 32 * 1024;
        const int rk = isnew ? (r & 15) : r;
        f32x16 sc;
#pragma unroll
        for (int i = 0; i < 16; ++i) sc[i] = 0.f;
        const float* kp = kbase + (size_t)rk * 1024 + 8 * hh;
#pragma unroll
        for (int s = 0; s < 8; ++s) {
            const f32x4 a = *(const f32x4*)(kp + 16 * s), c = *(const f32x4*)(kp + 16 * s + 4);
            u32x4 p; p.x = cvt_pk_bf16(a[0], a[1]); p.y = cvt_pk_bf16(a[2], a[3]); p.z = cvt_pk_bf16(c[0], c[1]); p.w = cvt_pk_bf16(c[2], c[3]);
            const bf16x8 qh = *(const LAS bf16x8*)(lds + SA_QH + s * 1024 + lane * 16);
            sc = MFMA32(__builtin_bit_cast(bf16x8, p), qh, sc);
        }
        if (isnew) {
#pragma unroll
            for (int i = 0; i < 16; ++i) if (crow(i, hh) >= 16) sc[i] = -1e30f;
        }
        float mx = max16(sc); mx = fmaxf(mx, __shfl_xor(mx, 32));
        const float mnew = fmaxf(m_run, mx), alpha = fast_exp2(m_run - mnew);
        m_run = mnew;
        float ls = 0.f;
#pragma unroll
        for (int i = 0; i < 16; ++i) { sc[i] = fast_exp2(sc[i] - mnew); ls += sc[i]; }
        l_run = l_run * alpha + ls;
        if (hh == 0) wsf[r] = alpha;
        asm volatile("s_waitcnt lgkmcnt(0)" ::: "memory");
#pragma unroll
        for (int i = 0; i < 16; ++i) { const float a = wsf[crow(i, hh)];
#pragma unroll
            for (int d = 0; d < 4; ++d) o[d][i] *= a; }
        bf16x8 pa[2]; pa[0] = pack8(sc, 0); pa[1] = pack8(sc, 1);
#pragma unroll
        for (int s = 0; s < 2; ++s) {
#pragma unroll
            for (int d = 0; d < 4; ++d) {
                float v[8];
#pragma unroll
                for (int j = 0; j < 8; ++j) { int key = 16 * s + 8 * (j >> 2) + 4 * hh + (j & 3); if (isnew) key &= 15; v[j] = vbase[(size_t)key * 1024 + d * 32 + r]; }
                u32x4 p; p.x = cvt_pk_bf16(v[0], v[1]); p.y = cvt_pk_bf16(v[2], v[3]); p.z = cvt_pk_bf16(v[4], v[5]); p.w = cvt_pk_bf16(v[6], v[7]);
                o[d] = MFMA32(pa[s], __builtin_bit_cast(bf16x8, p), o[d]);
            }
        }
    }
    { float lt = l_run + __shfl_xor(l_run, 32);
      LAS float* ml = (LAS float*)(lds + SA_ML) + w * 64;
      if (hh == 0) { ml[r] = m_run; ml[32 + r] = lt; }
      LAS float* op = (LAS float*)(lds + SA_O) + w * 4096;
#pragma unroll
      for (int d = 0; d < 4; ++d)
#pragma unroll
          for (int i = 0; i < 16; ++i) op[crow(i, hh) * 128 + d * 32 + r] = o[d][i]; }
    asm volatile("s_waitcnt lgkmcnt(0)" ::: "memory");
    __builtin_amdgcn_s_barrier();
    asm volatile("" ::: "memory");
    { const float* sg = C.in[11];
#pragma unroll
      for (int e = 0; e < 2; ++e) {
          const int t = 2 * w + e; float res[2][2];
#pragma unroll
          for (int c = 0; c < 2; ++c) {
              const int col = c * 16 + t; float M = -1e30f;
#pragma unroll
              for (int ww = 0; ww < 8; ++ww) M = fmaxf(M, ((LAS float*)(lds + SA_ML))[ww * 64 + col]);
              float L = 0.f, a0 = 0.f, a1 = 0.f;
#pragma unroll
              for (int ww = 0; ww < 8; ++ww) { const float sc = fast_exp2(((LAS float*)(lds + SA_ML))[ww * 64 + col] - M); L += ((LAS float*)(lds + SA_ML))[ww * 64 + 32 + col] * sc;
                  const LAS float* op = (LAS float*)(lds + SA_O) + ww * 4096 + col * 128; a0 += op[lane] * sc; a1 += op[64 + lane] * sc; }
              const float il = fast_rcp(L); res[c][0] = a0 * il; res[c][1] = a1 * il;
          }
          const float v0 = res[0][0] - lam * res[1][0], v1 = res[0][1] - lam * res[1][1];
          const float ss = wave_sum(v0 * v0 + v1 * v1);
          const float rstd = rsqrtf(ss * (1.0f / 128.0f) + RMS_EPS);
          bf16_t* cat = (bf16_t*)(C.ws + WS_CAT) + ((size_t)(MP + b * 16 + t)) * DM + h * 128;
          cat[lane] = f2bf(v0 * rstd * sg[lane] * (1.0f - LAM_INIT)); cat[64 + lane] = f2bf(v1 * rstd * sg[64 + lane] * (1.0f - LAM_INIT));
      } }
    asm volatile("s_waitcnt lgkmcnt(0)" ::: "memory");
    __builtin_amdgcn_s_barrier();
    asm volatile("" ::: "memory");
}

constexpr int LR_WF = 0, LR_XS = 16384, LR_XS_W = 9728, LR_XC = LR_XS + 8 * LR_XS_W, LR_COMP = LR_XC + 8 * 4096;
template <bool SAMPLE> __device__ __forceinline__ void lru_unit(const Ctx& C, int b, int cb) {
    LAS unsigned char* lds = C.lds; int lane_ = C.lane, w_ = C.wave; asm volatile("" : "+v"(lane_)); asm volatile("" : "+s"(w_));
    const int lane = lane_, w = w_, tid = w * 64 + lane, j = lane & 31, hh = lane >> 5;
    const float* XBR = (const float*)(C.ws + WS_XBR); const bf16_t* GB = (const bf16_t*)(C.ws + WS_GB); bf16_t* CAT = (bf16_t*)(C.ws + WS_CAT);
    for (int e = tid; e < 1024; e += NTHREADS) {
        const int l = e & 63, s = (e >> 6) & 3, nb = (e >> 8) & 1, gate = e >> 9; const int jj0 = 16 * s + 8 * (l >> 5), col = 32 * nb + (l & 31);
        const float* Wg = (gate ? C.in[16] : C.in[14]) + (size_t)cb * 4096;
        float v[8];
#pragma unroll
        for (int q = 0; q < 8; ++q) v[q] = Wg[(jj0 + q) * 64 + col];
        u32x4 p; p.x = cvt_pk_bf16(v[0], v[1]); p.y = cvt_pk_bf16(v[2], v[3]); p.z = cvt_pk_bf16(v[4], v[5]); p.w = cvt_pk_bf16(v[6], v[7]);
        *(LAS u32x4*)(lds + LR_WF + e * 16) = p;
    }
    float cw[2][4], cbias[2], ba[2], bi[2], spl[2];
#pragma unroll
    for (int nb = 0; nb < 2; ++nb) { const int ch = cb * 64 + 32 * nb + j;
#pragma unroll
        for (int q = 0; q < 4; ++q) cw[nb][q] = C.in[12][q * 1024 + ch];
        cbias[nb] = C.in[13][ch]; ba[nb] = C.in[15][ch]; bi[nb] = C.in[17][ch];
        const float L = C.in[18][ch]; const float sp = (L < -15.f) ? -L : log1pf(expf(-L));
        spl[nb] = 8.0f * sp * LOG2E; }
    asm volatile("s_waitcnt lgkmcnt(0)" ::: "memory");
    __builtin_amdgcn_s_barrier();
    asm volatile("" ::: "memory");
    LAS float* XS = (LAS float*)(lds + LR_XS + w * LR_XS_W);
    LAS unsigned char* XC = lds + LR_XC + w * 4096;
    float carry[2] = {0.f, 0.f};
    const int NR = SAMPLE ? 1 : 16;
#pragma unroll 1
    for (int rr = 0; rr < NR; ++rr) {
        const int t0 = rr * 256 + w * 32;
        if constexpr (!SAMPLE) {
#pragma unroll 1
            for (int idx = lane; idx < 35 * 16; idx += 64) { const int row = idx >> 4, c4 = idx & 15, tt = t0 - 3 + row;
                f32x4 v = (f32x4){0.f, 0.f, 0.f, 0.f}; if (tt >= 0) v = *(const f32x4*)(XBR + ((size_t)(b * 4096 + tt)) * 1024 + cb * 64 + c4 * 4);
                *(LAS f32x4*)(XS + row * 64 + c4 * 4) = v; }
        } else {
#pragma unroll 1
            for (int idx = lane; idx < 38 * 16; idx += 64) { const int row = idx >> 4, c4 = idx & 15, bl = row >= 19 ? 1 : 0, k = row - 19 * bl, bb = 2 * w + bl;
                const float* src = (k < 3) ? C.in[5] + ((size_t)(bb * 3 + k)) * 1024 + cb * 64 + c4 * 4 : XBR + ((size_t)(MP + bb * 16 + (k - 3))) * 1024 + cb * 64 + c4 * 4;
                *(LAS f32x4*)(XS + row * 64 + c4 * 4) = *(const f32x4*)src; }
        }
        asm volatile("s_waitcnt lgkmcnt(0)" ::: "memory");
        float xc[2][16];
#pragma unroll
        for (int nb = 0; nb < 2; ++nb)
#pragma unroll
            for (int g = 0; g < 4; ++g) {
                int tb = 8 * g + 4 * hh; if constexpr (SAMPLE) tb = (g >> 1) * 19 + 8 * (g & 1) + 4 * hh;
                float x[7];
#pragma unroll
                for (int k = 0; k < 7; ++k) x[k] = XS[(tb + k) * 64 + 32 * nb + j];
#pragma unroll
                for (int i = 0; i < 4; ++i) xc[nb][4 * g + i] = cbias[nb] + cw[nb][0] * x[i] + cw[nb][1] * x[i + 1] + cw[nb][2] * x[i + 2] + cw[nb][3] * x[i + 3];
            }
#pragma unroll
        for (int nb = 0; nb < 2; ++nb)
#pragma unroll
            for (int q = 0; q < 16; ++q) { const int row = crow(q, hh), ch = 32 * nb + j;
                *(LAS unsigned short*)(XC + row * 128 + (((ch >> 3) ^ ((row >> 1) & 7)) * 16) + (ch & 7) * 2) = f2bf(xc[nb][q]); }
        asm volatile("s_waitcnt lgkmcnt(0)" ::: "memory");
        bf16x8 xa[4];
#pragma unroll
        for (int s = 0; s < 4; ++s) xa[s] = *(const LAS bf16x8*)(XC + j * 128 + (((2 * s + hh) ^ ((j >> 1) & 7)) * 16));
        float av[2][16], uv[2][16];
#pragma unroll
        for (int nb = 0; nb < 2; ++nb) {
            f32x16 acc;
#pragma unroll
            for (int i = 0; i < 16; ++i) acc[i] = 0.f;
#pragma unroll
            for (int s = 0; s < 4; ++s) acc = MFMA32(xa[s], *(const LAS bf16x8*)(lds + LR_WF + ((0 * 2 + nb) * 4 + s) * 1024 + lane * 16), acc);
#pragma unroll
            for (int i = 0; i < 16; ++i) { const float rg = sigmoidf_(acc[i] + ba[nb]); av[nb][i] = fast_exp2(-rg * spl[nb]); }
#pragma unroll
            for (int i = 0; i < 16; ++i) acc[i] = 0.f;
#pragma unroll
            for (int s = 0; s < 4; ++s) acc = MFMA32(xa[s], *(const LAS bf16x8*)(lds + LR_WF + ((1 * 2 + nb) * 4 + s) * 1024 + lane * 16), acc);
#pragma unroll
            for (int i = 0; i < 16; ++i) { const float ig = sigmoidf_(acc[i] + bi[nb]); const float a = av[nb][i];
                uv[nb][i] = sqrtf(fmaxf(1.0f - a * a, 0.f)) * ig * xc[nb][i]; }
        }
        float Hc[2], Pc[2];
#pragma unroll
        for (int nb = 0; nb < 2; ++nb) {
            Hc[nb] = 0.f; Pc[nb] = 1.f;
#pragma unroll
            for (int g = 0; g < 4; ++g) {
#pragma unroll
                for (int i = 1; i < 4; ++i) { uv[nb][4 * g + i] = av[nb][4 * g + i] * uv[nb][4 * g + i - 1] + uv[nb][4 * g + i]; av[nb][4 * g + i] = av[nb][4 * g + i] * av[nb][4 * g + i - 1]; }
                if (SAMPLE && g == 2) { Hc[nb] = 0.f; Pc[nb] = 1.f; }
                float nH = uv[nb][4 * g + 3] + av[nb][4 * g + 3] * Hc[nb], nP = av[nb][4 * g + 3] * Pc[nb];
                const float rH = __shfl_xor(nH, 32), rP = __shfl_xor(nP, 32);
                if (hh == 1) { Hc[nb] = rH; Pc[nb] = rP; }
                const float l3h = uv[nb][4 * g + 3], l3p = av[nb][4 * g + 3];
#pragma unroll
                for (int i = 0; i < 4; ++i) { uv[nb][4 * g + i] = uv[nb][4 * g + i] + av[nb][4 * g + i] * Hc[nb]; av[nb][4 * g + i] = av[nb][4 * g + i] * Pc[nb]; }
                nH = l3h + l3p * Hc[nb]; nP = l3p * Pc[nb];
                const float r2H = __shfl_xor(nH, 32), r2P = __shfl_xor(nP, 32);
                if (hh == 0) { Hc[nb] = r2H; Pc[nb] = r2P; } else { Hc[nb] = nH; Pc[nb] = nP; }
            }
        }
        float cin[2][2];
        if constexpr (!SAMPLE) {
            LAS float* CP = (LAS float*)(lds + LR_COMP) + (rr & 1) * 1024;
            if (hh == 1) {
#pragma unroll
                for (int nb = 0; nb < 2; ++nb) { CP[(w * 64 + 32 * nb + j) * 2] = Pc[nb]; CP[(w * 64 + 32 * nb + j) * 2 + 1] = Hc[nb]; } }
            asm volatile("s_waitcnt lgkmcnt(0)" ::: "memory");
            __builtin_amdgcn_s_barrier();
            asm volatile("" ::: "memory");
#pragma unroll
            for (int nb = 0; nb < 2; ++nb) { float c = carry[nb]; cin[nb][0] = c;
#pragma unroll
                for (int ww = 0; ww < 8; ++ww) { if (ww == w) cin[nb][0] = c; const f32x2 ph = *(const LAS f32x2*)(CP + (ww * 64 + 32 * nb + j) * 2); c = ph.x * c + ph.y; }
                carry[nb] = c; cin[nb][1] = cin[nb][0]; }
        } else {
#pragma unroll
            for (int nb = 0; nb < 2; ++nb) { cin[nb][0] = C.in[4][(size_t)(2 * w) * 1024 + cb * 64 + 32 * nb + j]; cin[nb][1] = C.in[4][(size_t)(2 * w + 1) * 1024 + cb * 64 + 32 * nb + j]; }
        }
        LAS float* HT = XS;
#pragma unroll
        for (int nb = 0; nb < 2; ++nb)
#pragma unroll
            for (int q = 0; q < 16; ++q) {
                const int rho = crow(q, hh); const float hval = uv[nb][q] + av[nb][q] * cin[nb][SAMPLE ? (q >> 3) : 0];
                HT[rho * 64 + 32 * nb + j] = hval;
            }
        asm volatile("s_waitcnt lgkmcnt(0)" ::: "memory");
        {
            const int rho = lane >> 1, c0 = (lane & 1) * 32;
            size_t row; if constexpr (!SAMPLE) row = (size_t)(b * 4096 + t0 + rho); else row = (size_t)(MP + (2 * w + (rho >> 4)) * 16 + (rho & 15));
            const bf16_t* gp = GB + row * 1024 + cb * 64 + c0; bf16_t* op = CAT + row * DM + 1024 + cb * 64 + c0;
            const LAS float* hp = HT + rho * 64 + c0;
#pragma unroll
            for (int k = 0; k < 4; ++k) {
                const u32x4 gv = *(const u32x4*)(gp + 8 * k); const f32x4 h0 = *(const LAS f32x4*)(hp + 8 * k), h1 = *(const LAS f32x4*)(hp + 8 * k + 4);
                u32x4 ov;
                ov.x = cvt_pk_bf16(h0[0] * __uint_as_float(gv.x << 16), h0[1] * __uint_as_float(gv.x & 0xffff0000u));
                ov.y = cvt_pk_bf16(h0[2] * __uint_as_float(gv.y << 16), h0[3] * __uint_as_float(gv.y & 0xffff0000u));
                ov.z = cvt_pk_bf16(h1[0] * __uint_as_float(gv.z << 16), h1[1] * __uint_as_float(gv.z & 0xffff0000u));
                ov.w = cvt_pk_bf16(h1[2] * __uint_as_float(gv.w << 16), h1[3] * __uint_as_float(gv.w & 0xffff0000u));
                *(u32x4*)(op + 8 * k) = ov;
            }
            if constexpr (SAMPLE) { if ((rho & 15) == 15) { float* hs = C.out + O_HS + (size_t)(2 * w + (rho >> 4)) * 1024 + cb * 64 + c0;
#pragma unroll
                for (int k = 0; k < 8; ++k) *(f32x4*)(hs + 4 * k) = *(const LAS f32x4*)(hp + 4 * k); } }
        }
        asm volatile("s_waitcnt lgkmcnt(0)" ::: "memory");
    }
    if constexpr (!SAMPLE) {
        if (w == 0 && hh == 0) {
#pragma unroll
            for (int nb = 0; nb < 2; ++nb) C.out[O_HP + (size_t)b * 1024 + cb * 64 + 32 * nb + j] = carry[nb]; }
        if (tid < 192) { const int k = tid >> 6, ch = cb * 64 + (tid & 63); C.out[O_CP + (size_t)(b * 3 + k) * 1024 + ch] = XBR[((size_t)(b * 4096 + 4093 + k)) * 1024 + ch]; }
    } else {
        for (int e = tid; e < 16 * 3 * 64; e += NTHREADS) { const int ch = cb * 64 + (e & 63), k = (e >> 6) % 3, bb = e / 192;
            C.out[O_CS + (size_t)(bb * 3 + k) * 1024 + ch] = XBR[((size_t)(MP + bb * 16 + 13 + k)) * 1024 + ch]; }
    }
    asm volatile("s_waitcnt lgkmcnt(0)" ::: "memory");
    __builtin_amdgcn_s_barrier();
    asm volatile("" ::: "memory");
}

__device__ __forceinline__ void ln_rows(const Ctx& C, const float* src, float* dstf, bf16_t* dstb, const float* g, const float* bta) {
    const int gw = C.bid * NWAVES + C.wave, NGW = C.G * NWAVES, lane = C.lane;
    for (int m = gw; m < MT; m += NGW) {
        const f32x4* xr = (const f32x4*)(src + (size_t)m * DM) + lane;
        f32x4 v[8]; float s = 0.f;
#pragma unroll
        for (int k = 0; k < 8; ++k) { v[k] = xr[64 * k]; s += (v[k][0] + v[k][1]) + (v[k][2] + v[k][3]); }
        const float mean = wave_sum(s) * (1.0f / DM); float s2 = 0.f;
#pragma unroll
        for (int k = 0; k < 8; ++k) { v[k] = v[k] - mean; s2 += (v[k][0] * v[k][0] + v[k][1] * v[k][1]) + (v[k][2] * v[k][2] + v[k][3] * v[k][3]); }
        const float rstd = rsqrtf(wave_sum(s2) * (1.0f / DM) + LN_EPS);
#pragma unroll
        for (int k = 0; k < 8; ++k) {
            const f32x4 gg = ((const f32x4*)g)[64 * k + lane], bb = ((const f32x4*)bta)[64 * k + lane];
            const f32x4 y = v[k] * rstd * gg + bb;
            ((f32x4*)(dstf + (size_t)m * DM))[64 * k + lane] = y;
            if (dstb) *(u32x2*)(dstb + (size_t)m * DM + (64 * k + lane) * 4) = (u32x2){cvt_pk_bf16(y[0], y[1]), cvt_pk_bf16(y[2], y[3])};
        }
    }
}

__global__ void __launch_bounds__(NTHREADS, 2) hymba_fwd(Args args) {
    extern __shared__ __attribute__((aligned(16))) unsigned char lds_raw[];
    Ctx C; C.lds = (LAS unsigned char*)lds_raw; C.tid = threadIdx.x; C.lane = C.tid & 63; C.wave = __builtin_amdgcn_readfirstlane(C.tid >> 6);
    C.G = gridDim.x; C.bid = blockIdx.x; C.in = args.in; C.out = args.out; C.ws = args.ws;
    cg::grid_group grid = cg::this_grid();
    const int lo = args.ph_lo, hi = args.ph_hi;
#ifndef PH_MASK
#define PH_MASK 0xff
#endif
#define IN(k) (((PH_MASK >> (k)) & 1) && lo <= (k) && (k) < hi)
#define SEAM(k) do { if (IN(k) && IN((k) + 1)) grid.sync(); } while (0)
    unsigned char* ws = args.ws;

    if (IN(0)) { p0_prologue(C); }
    SEAM(0);
    if (IN(1)) {
        pg8::Gemm g{(const bf16_t*)(ws + WS_XB), (const bf16_t*)(ws + WS_WIN), MT, INC, DM}; pg8::StaticOrder S; S.init(MT, INC, C.G, C.bid);
        EpiIn E{(bf16_t*)(ws + WS_QP), (bf16_t*)(ws + WS_KP), (bf16_t*)(ws + WS_VP), (bf16_t*)(ws + WS_QS), (float*)(ws + WS_XBR), (bf16_t*)(ws + WS_GB), args.out, (const float*)(ws + WS_ROPE)};
        pg8::gemm_phase<EpiIn, pg8::StaticOrder, true, true>(C.lds, g, S, E);
    }
    SEAM(1);
    if (IN(2)) {
        float lam;
        { const float a = (C.lane < 64) ? args.in[7][C.lane] * args.in[8][C.lane] : 0.f, b2 = args.in[9][C.lane] * args.in[10][C.lane];
          lam = expf(wave_sum(a)) - expf(wave_sum(b2)) + LAM_INIT; }
        unsigned* ctr = (unsigned*)(ws + WS_CTL);
        LAS unsigned* slot = (LAS unsigned*)(C.lds + LDS_BYTES - 64);
        for (;;) {
            if (C.tid == 0) slot[0] = atomicAdd(ctr, 1u);
            asm volatile("s_waitcnt vmcnt(0) lgkmcnt(0)" ::: "memory");
            __builtin_amdgcn_s_barrier();
            asm volatile("" ::: "memory");
            const int item = (int)__builtin_amdgcn_readfirstlane(slot[0]);
            asm volatile("s_waitcnt lgkmcnt(0)" ::: "memory");
            __builtin_amdgcn_s_barrier();
            asm volatile("" ::: "memory");
            if (item >= 32 + 128 + 512 + 16) break;
#ifndef P2_MASK
#define P2_MASK 15
#endif
            if (item < 32) { if (P2_MASK & 1) lru_unit<false>(C, item >> 4, item & 15); }
            else if (item < 160) { if (P2_MASK & 2) { const int k = item - 32; attn_sample_unit(C, k >> 3, k & 7, lam); } }
            else if (item < 672) { if (P2_MASK & 4) { const int k = item - 160; const int qi = 31 - (k >> 4), bh = k & 15; attn_prompt_unit(C, bh >> 3, bh & 7, qi, lam); } }
            else { if (P2_MASK & 8) lru_unit<true>(C, 0, item - 672); }
        }
    }
    SEAM(2);
    if (IN(3)) {
        pg8::Gemm g{(const bf16_t*)(ws + WS_CAT), (const bf16_t*)(ws + WS_WOUT), MT, DM, DM}; pg8::StaticOrder S; S.init(MT, DM, C.G, C.bid);
        EpiAxpy E{args.in[0], args.in[1], (float*)(ws + WS_Y1)};
        pg8::gemm_phase<EpiAxpy, pg8::StaticOrder, true, true>(C.lds, g, S, E);
    }
    SEAM(3);
    if (IN(4)) { ln_rows(C, (const float*)(ws + WS_Y1), (float*)(ws + WS_Y1), (bf16_t*)(ws + WS_X1B), args.in[20], args.in[21]); }
    SEAM(4);
    if (IN(5)) {
        pg8::Gemm g{(const bf16_t*)(ws + WS_X1B), (const bf16_t*)(ws + WS_WUP), MT, DFF, DM}; pg8::StaticOrder S; S.init(MT, DFF, C.G, C.bid);
        EpiUp E{(bf16_t*)(ws + WS_H)};
        pg8::gemm_phase<EpiUp, pg8::StaticOrder, true, true>(C.lds, g, S, E);
    }
    SEAM(5);
    if (IN(6)) {
        pg8::Gemm g{(const bf16_t*)(ws + WS_H), (const bf16_t*)(ws + WS_WDOWN), MT, DM, DFF}; pg8::StaticOrder S; S.init(MT, DM, C.G, C.bid);
        const float* x1 = (const float*)(ws + WS_Y1);
        EpiAxpy E{x1, x1 + (size_t)MP * DM, args.out};
        pg8::gemm_phase<EpiAxpy, pg8::StaticOrder, true, true>(C.lds, g, S, E);
    }
    SEAM(6);
    if (IN(7)) { ln_rows(C, args.out, args.out, nullptr, args.in[24], args.in[25]); }
#undef IN
#undef SEAM
}

extern "C" void kernel_launch(void* const* d_in, const int* in_sizes, int n_in, void* d_out, int out_size, void* d_ws, size_t ws_size, hipStream_t stream) {
    static int grid = 0;
    if (grid == 0) {
        if (n_in != 26 || out_size != (int)O_END || ws_size < WS_END) { fprintf(stderr, "kernel_launch: unexpected shapes: n_in %d out %d ws %zu\n", n_in, out_size, ws_size); grid = -1; return; }
        int dev = 0, cus = 0, per_cu = 0;
        hipGetDevice(&dev); hipDeviceGetAttribute(&cus, hipDeviceAttributeMultiprocessorCount, dev);
        if (hipFuncSetAttribute((const void*)hymba_fwd, hipFuncAttributeMaxDynamicSharedMemorySize, LDS_BYTES) != hipSuccess) { fprintf(stderr, "kernel_launch: hipFuncSetAttribute failed\n"); grid = -1; return; }
        hipOccupancyMaxActiveBlocksPerMultiprocessor(&per_cu, (const void*)hymba_fwd, NTHREADS, LDS_BYTES);
        if (per_cu < 1) { fprintf(stderr, "kernel_launch: occupancy query says %d blocks per CU\n", per_cu); grid = -1; return; }
        grid = cus;
        fprintf(stderr, "kernel_launch: %d CUs, occupancy %d blocks/CU, grid %d\n", cus, per_cu, grid);
    }
    if (grid < 0) return;
    hipMemsetAsync((char*)d_ws + WS_CTL, 0, CTL_BYTES, stream);
    Args a{};
    for (int i = 0; i < 26; ++i) a.in[i] = (const float*)d_in[i];
    a.out = (float*)d_out; a.ws = (unsigned char*)d_ws;
    constexpr int NPH = 8;
    for (int li = 0; li < MK_N_LAUNCHES; ++li) {
        a.ph_lo = (MK_N_LAUNCHES == 1) ? 0 : li; a.ph_hi = (MK_N_LAUNCHES == 1) ? NPH : li + 1;
        void* kargs[] = {&a};
        hipError_t e = hipLaunchCooperativeKernel((const void*)hymba_fwd, dim3(grid), dim3(NTHREADS), kargs, LDS_BYTES, stream);
        if (e != hipSuccess) { fprintf(stderr, "kernel_launch: cooperative launch %d failed: %s\n", li, hipGetErrorString(e)); break; }
    }
}
```

```cpp
#include <hip/hip_runtime.h>
#include <hip/hip_cooperative_groups.h>
#include <cstdio>
#include <cstdint>
namespace cg = cooperative_groups;

#ifndef MK_N_LAUNCHES
#define MK_N_LAUNCHES 1
#endif

#define LAS __attribute__((address_space(3)))
typedef unsigned short bf16_t;
typedef short bf16x8 __attribute__((ext_vector_type(8)));
typedef short s16x4 __attribute__((ext_vector_type(4)));
typedef float f32x2 __attribute__((ext_vector_type(2)));
typedef float f32x4 __attribute__((ext_vector_type(4)));
typedef float f32x16 __attribute__((ext_vector_type(16)));
typedef unsigned u32x2 __attribute__((ext_vector_type(2)));
typedef unsigned u32x4 __attribute__((ext_vector_type(4)));

constexpr int DM = 2048, SEQ = 4096, NBP = 2, NBS = 16, TS = 16, PAST = 2048;
constexpr int MP = NBP * SEQ, MS = NBS * TS, MT = MP + MS;
constexpr int AW = 1024, LW = 1024, NH = 8, INC = 5120, DFF = 8192;
constexpr float LN_EPS = 1e-5f, RMS_EPS = 1e-5f;
constexpr float DN_ALPHA = 1.189207115002721f;
constexpr float LAM_INIT = 0.2f;
constexpr float QSCALE = 0.125f * 1.4426950408889634f;
constexpr float LOG2E = 1.4426950408889634f;

constexpr size_t O_YP = 0, O_YS = 16777216, O_KP = 17301504, O_VP = 25690112, O_HP = 34078720, O_CP = 34080768,
                 O_KS = 34086912, O_VS = 34349056, O_HS = 34611200, O_CS = 34627584, O_END = 34676736;

constexpr size_t MiB = 1u << 20;
constexpr size_t WS_CTL = 0, CTL_BYTES = 65536;
constexpr size_t WS_ROPE = 1 * MiB;
constexpr size_t WS_WIN = 3 * MiB;
constexpr size_t WS_WOUT = 23 * MiB;
constexpr size_t WS_WUP = 31 * MiB;
constexpr size_t WS_WDOWN = 63 * MiB;
constexpr size_t WS_XB = 95 * MiB;
constexpr size_t WS_QP = 128 * MiB;
constexpr size_t WS_KP = 144 * MiB;
constexpr size_t WS_VP = 160 * MiB;
constexpr size_t WS_QS = 176 * MiB;
constexpr size_t WS_XBR = 177 * MiB;
constexpr size_t WS_GB = 210 * MiB;
constexpr size_t WS_CAT = 227 * MiB;
constexpr size_t WS_Y1 = 260 * MiB;
constexpr size_t WS_X1B = 326 * MiB;
constexpr size_t WS_H = 359 * MiB;
constexpr size_t WS_END = 491 * MiB;
constexpr size_t WS_PART3 = 95 * MiB;
constexpr size_t WS_PART5 = 95 * MiB;
constexpr size_t WS_PART6 = 160 * MiB;
constexpr int KS3 = 8, KS5 = 8, KS6 = 32;

constexpr int LDS_BYTES = 147456;
constexpr int NWAVES = 8, NTHREADS = 512;

__device__ __forceinline__ unsigned cvt_pk_bf16(float lo, float hi) { unsigned r; asm volatile("v_cvt_pk_bf16_f32 %0, %1, %2" : "=v"(r) : "v"(lo), "v"(hi)); return r; }
__device__ __forceinline__ unsigned short f2bf(float f) { return (unsigned short)(cvt_pk_bf16(f, 0.f) & 0xffffu); }
__device__ __forceinline__ float bf2f(unsigned short b) { return __uint_as_float(((unsigned)b) << 16); }
__device__ __forceinline__ float fast_exp2(float x) { return __builtin_amdgcn_exp2f(x); }
__device__ __forceinline__ float fast_rcp(float x) { return __builtin_amdgcn_rcpf(x); }
__device__ __forceinline__ float sigmoidf_(float x) { return fast_rcp(1.0f + fast_exp2(-x * LOG2E)); }
__device__ __forceinline__ float gelu_tanh(float x) { const float z = 0.7978845608028654f * (x + 0.044715f * x * x * x); return x * fast_rcp(1.0f + fast_exp2(-2.0f * LOG2E * z)); }
__device__ __forceinline__ int crow(int reg, int h) { return (reg & 3) + 8 * (reg >> 2) + 4 * h; }
__device__ __forceinline__ float wave_sum(float v) {
#pragma unroll
    for (int o = 1; o < 64; o <<= 1) v += __shfl_xor(v, o);
    return v;
}
#define MFMA32(a, b, c) __builtin_amdgcn_mfma_f32_32x32x16_bf16((a), (b), (c), 0, 0, 0)

namespace pg8 {
constexpr int BM = 256, BK = 64, HALF = 128, HTB = HALF * BK * 2, STAGE_BYTES = 8 * HTB, NXCD = 8, WGM = 8;
__host__ __device__ __forceinline__ int lds_byte(int r, int c) { const int st = (r >> 4) * 2 + (c >> 5), rr = r & 15, cc = c & 31, ob = rr * 64 + cc * 2; return st * 1024 + (ob ^ (((ob >> 9) & 1) << 5)); }
__host__ __device__ __forceinline__ void stage_rc(int b, int& R, int& C) { const int st = b / 1024, sb = b % 1024, swz = sb ^ (((sb >> 9) & 1) << 5); R = (st >> 1) * 16 + swz / 64; C = (st & 1) * 32 + (swz % 64) / 2; }
__host__ __device__ __forceinline__ int perm32(int rho) { const int n = rho >> 4, i = rho & 15; return 8 * (i >> 2) + 4 * n + (i & 3); }

struct Unit { int pm, pn, ks, nt; };
struct Gemm { const bf16_t* A; const bf16_t* Bt; int M, N, K; };

struct ComboOrder {
    int nM, nN, nwg, G, c, ntk, ksplit, nsu;
    __host__ __device__ void init(int Mp, int N, int K, int ksplit_, int G_, int c_) { nM = Mp / BM; nN = N / BM; nwg = nM * nN; G = G_; c = c_; ntk = K / BK; ksplit = ksplit_; nsu = nN * ksplit_; }
    __host__ __device__ bool next(int i, Unit& u) const {
        const long L = (long)i * G + c; if (L >= nwg + nsu) return false;
        if (L >= nwg) { const int ls = (int)(L - nwg); u.pm = nM; u.pn = ls % nN; u.ks = ls / nN; u.nt = ntk / ksplit; return true; }
        int wgid = (int)L; { const int q = nwg / NXCD, r = nwg % NXCD, xcd = wgid % NXCD, off = wgid / NXCD; wgid = (xcd < r ? xcd * (q + 1) : r * (q + 1) + (xcd - r) * q) + off; }
        const int nig = WGM * nN, gid = wgid / nig, fm = gid * WGM, gsz = (nM - fm) < WGM ? (nM - fm) : WGM;
        u.pm = fm + ((wgid % nig) % gsz); u.pn = (wgid % nig) / gsz; u.ks = 0; u.nt = ntk; return true;
    }
    __device__ __forceinline__ void a_ready(const Unit&) const {}
    __device__ __forceinline__ void done(const Unit&) const {}
};

template <class Epi, class Sched, bool ALIGN_EPI = false, bool SP2 = false>
__device__ __forceinline__ void gemm_phase(LAS unsigned char* lds, const Gemm g, const Sched& S, const Epi& E) {
    const int tid = threadIdx.x, wid = __builtin_amdgcn_readfirstlane(tid >> 6), lane = tid & 63, wr = wid >> 2, wc = wid & 3, fr = lane & 15, fq = lane >> 4;
    const int K = g.K;
    unsigned voffA[2], voffB[2];
#pragma unroll
    for (int i = 0; i < 2; ++i) { int R, C; stage_rc(tid * 16 + i * 8192, R, C); const int Rb = Epi::PERM ? ((R & ~31) + perm32(R & 31)) : R;
        voffA[i] = (unsigned)(R * K + C) * 2u; voffB[i] = (unsigned)(Rb * K + C) * 2u; }
    const size_t kstep = (size_t)(BK * 2);
    const size_t hstep = (size_t)HALF * K * 2;
    const size_t tstep = 2 * hstep;
    const unsigned ldsw = (unsigned)wid * 1024u;
    const int aoff = lds_byte(wr * 64 + fr, fq * 8), boff = lds_byte(wc * 32 + fr, fq * 8);
#define PG8_SA(b, h) (((b) * 2 + (h)) * HTB)
#define PG8_SB(b, h) ((4 + (b) * 2 + (h)) * HTB)
#define PG8_STAGE(bufoff, gbase, voff) do { _Pragma("unroll") for (int _i = 0; _i < 2; ++_i) \
        __builtin_amdgcn_global_load_lds((const unsigned*)((const char*)(gbase) + (voff)[_i]), (LAS unsigned*)(lds + (bufoff) + ldsw + _i * 8192), 16, 0, 0); } while (0)
#define PG8_LDA(dst, b, h) do { _Pragma("unroll") for (int m = 0; m < 4; ++m) _Pragma("unroll") for (int k = 0; k < 2; ++k) dst[m][k] = *(const LAS bf16x8*)(lds + PG8_SA(b, h) + aoff + m * 2048 + k * 1024); } while (0)
#define PG8_LDB(dst, b, h) do { _Pragma("unroll") for (int n = 0; n < 2; ++n) _Pragma("unroll") for (int k = 0; k < 2; ++k) dst[n][k] = *(const LAS bf16x8*)(lds + PG8_SB(b, h) + boff + n * 2048 + k * 1024); } while (0)
#define PG8_MMA(ai, bj, At, Bt) do { __builtin_amdgcn_s_setprio(1); _Pragma("unroll") for (int m = 0; m < 4; ++m) _Pragma("unroll") for (int n = 0; n < 2; ++n) _Pragma("unroll") for (int k = 0; k < 2; ++k) \
        acc[ai][bj][m][n] = __builtin_amdgcn_mfma_f32_16x16x32_bf16(Bt[n][k], At[m][k], acc[ai][bj][m][n], 0, 0, 0); __builtin_amdgcn_s_setprio(0); } while (0)
#define PG8_WAIT_V(n) asm volatile("s_waitcnt vmcnt(" #n ")" ::: "memory")
#define PG8_WAIT_L(n) asm volatile("s_waitcnt lgkmcnt(" #n ")" ::: "memory")
#define PG8_BAR __builtin_amdgcn_s_barrier()
#define PG8_SCHED __builtin_amdgcn_sched_barrier(0)
    Unit cur, nxt; int ui = 0;
    if (!S.next(0, cur)) return;
    f32x4 acc[2][2][4][2];
#pragma unroll
    for (int a = 0; a < 2; ++a)
#pragma unroll
        for (int b = 0; b < 2; ++b)
#pragma unroll
            for (int m = 0; m < 4; ++m)
#pragma unroll
                for (int n = 0; n < 2; ++n) acc[a][b][m][n] = (f32x4){0.f, 0.f, 0.f, 0.f};
    bf16x8 At[4][2], B0[2][2], B1[2][2];
    const char* cA = (const char*)g.A + (size_t)cur.pm * tstep + (size_t)cur.ks * cur.nt * kstep; const char* cB = (const char*)g.Bt + (size_t)cur.pn * tstep + (size_t)cur.ks * cur.nt * kstep;
    S.a_ready(cur);
    if constexpr (SP2) {
        PG8_STAGE(PG8_SB(0, 0), cB, voffB); PG8_STAGE(PG8_SB(0, 1), cB + hstep, voffB); PG8_STAGE(PG8_SA(0, 0), cA, voffA); PG8_STAGE(PG8_SA(0, 1), cA + hstep, voffA);
        if (wr == 1) PG8_BAR;
        PG8_WAIT_V(2); PG8_BAR;
        PG8_STAGE(PG8_SB(1, 0), cB + kstep, voffB); PG8_STAGE(PG8_SA(1, 0), cA + kstep, voffA); PG8_STAGE(PG8_SB(1, 1), cB + hstep + kstep, voffB);
        PG8_WAIT_V(6); PG8_BAR;
    } else {
        PG8_STAGE(PG8_SB(0, 0), cB, voffB); PG8_STAGE(PG8_SA(0, 0), cA, voffA); PG8_STAGE(PG8_SB(0, 1), cB + hstep, voffB); PG8_STAGE(PG8_SA(0, 1), cA + hstep, voffA);
        if (wr == 1) PG8_BAR;
        PG8_WAIT_V(4); PG8_BAR;
        PG8_STAGE(PG8_SB(1, 0), cB + kstep, voffB); PG8_STAGE(PG8_SA(1, 0), cA + kstep, voffA); PG8_STAGE(PG8_SB(1, 1), cB + hstep + kstep, voffB);
        PG8_WAIT_V(6); PG8_BAR;
    }
    for (;;) {
        const bool has_next = S.next(ui + 1, nxt);
        const char* nA = has_next ? (const char*)g.A + (size_t)nxt.pm * tstep + (size_t)nxt.ks * nxt.nt * kstep : cA; const char* nB = has_next ? (const char*)g.Bt + (size_t)nxt.pn * tstep + (size_t)nxt.ks * nxt.nt * kstep : cB;
        const int nt = cur.nt;
        for (int t = 0; t < nt; t += 2) {
            const bool last = (t == nt - 2);
            const char* a1 = cA + (size_t)(t + 1) * kstep;
            const char* a2 = last ? nA : cA + (size_t)(t + 2) * kstep; const char* b2 = last ? nB : cB + (size_t)(t + 2) * kstep;
            const char* a3 = a2 + kstep; const char* b3 = b2 + kstep;
            if (last && has_next) S.a_ready(nxt);
            if constexpr (SP2) {
            PG8_LDB(B0, 0, 0); PG8_LDB(B1, 0, 1); PG8_SCHED; PG8_LDA(At, 0, 0); PG8_STAGE(PG8_SA(1, 1), a1 + hstep, voffA);
            PG8_WAIT_V(8); PG8_WAIT_L(0); PG8_BAR; PG8_MMA(0, 0, At, B0); PG8_MMA(0, 1, At, B1); PG8_BAR; PG8_SCHED;
            PG8_LDA(At, 0, 1); PG8_STAGE(PG8_SB(0, 0), b2, voffB); PG8_STAGE(PG8_SB(0, 1), b2 + hstep, voffB); PG8_STAGE(PG8_SA(0, 0), a2, voffA);
            PG8_WAIT_V(8); PG8_WAIT_L(0); PG8_BAR; PG8_MMA(1, 0, At, B0); PG8_MMA(1, 1, At, B1); PG8_BAR; PG8_SCHED;
            PG8_LDB(B0, 1, 0); PG8_LDB(B1, 1, 1); PG8_SCHED; PG8_LDA(At, 1, 0); PG8_STAGE(PG8_SA(0, 1), a2 + hstep, voffA);
            PG8_WAIT_V(8); PG8_WAIT_L(0); PG8_BAR; PG8_MMA(0, 0, At, B0); PG8_MMA(0, 1, At, B1); PG8_BAR; PG8_SCHED;
            PG8_LDA(At, 1, 1); PG8_STAGE(PG8_SB(1, 0), b3, voffB); PG8_STAGE(PG8_SB(1, 1), b3 + hstep, voffB); PG8_STAGE(PG8_SA(1, 0), a3, voffA);
            PG8_WAIT_V(8); PG8_WAIT_L(0); PG8_BAR; PG8_MMA(1, 0, At, B0); PG8_MMA(1, 1, At, B1); PG8_BAR; PG8_SCHED;
            } else {
            PG8_LDB(B0, 0, 0); PG8_SCHED; PG8_LDA(At, 0, 0); PG8_STAGE(PG8_SA(1, 1), a1 + hstep, voffA);
            PG8_WAIT_L(8); PG8_BAR; PG8_WAIT_L(0); PG8_MMA(0, 0, At, B0); PG8_BAR; PG8_SCHED;
            PG8_LDB(B1, 0, 1); PG8_STAGE(PG8_SB(0, 0), b2, voffB);
            PG8_BAR; PG8_WAIT_L(0); PG8_MMA(0, 1, At, B1); PG8_BAR;
            PG8_LDA(At, 0, 1); PG8_STAGE(PG8_SA(0, 0), a2, voffA);
            PG8_BAR; PG8_WAIT_L(0); PG8_MMA(1, 0, At, B0); PG8_BAR; PG8_SCHED;
            PG8_STAGE(PG8_SB(0, 1), b2 + hstep, voffB);
            PG8_WAIT_V(6); PG8_BAR; PG8_MMA(1, 1, At, B1); PG8_BAR;
            PG8_LDB(B0, 1, 0); PG8_SCHED; PG8_LDA(At, 1, 0); PG8_STAGE(PG8_SA(0, 1), a2 + hstep, voffA);
            PG8_WAIT_L(8); PG8_BAR; PG8_WAIT_L(0); PG8_MMA(0, 0, At, B0); PG8_BAR; PG8_SCHED;
            PG8_LDB(B1, 1, 1); PG8_STAGE(PG8_SB(1, 0), b3, voffB);
            PG8_BAR; PG8_WAIT_L(0); PG8_MMA(0, 1, At, B1); PG8_BAR;
            PG8_LDA(At, 1, 1); PG8_STAGE(PG8_SA(1, 0), a3, voffA);
            PG8_BAR; PG8_WAIT_L(0); PG8_MMA(1, 0, At, B0); PG8_BAR; PG8_SCHED;
            PG8_STAGE(PG8_SB(1, 1), b3 + hstep, voffB);
            PG8_WAIT_V(6); PG8_BAR; PG8_MMA(1, 1, At, B1); PG8_BAR;
            }
        }
        if constexpr (ALIGN_EPI) { if (wr == 0) PG8_BAR; }
        E(acc, cur, wr, wc, fr, fq); S.done(cur);
        if (!has_next) break;
#pragma unroll
        for (int a = 0; a < 2; ++a)
#pragma unroll
            for (int b = 0; b < 2; ++b)
#pragma unroll
                for (int m = 0; m < 4; ++m)
#pragma unroll
                    for (int n = 0; n < 2; ++n) acc[a][b][m][n] = (f32x4){0.f, 0.f, 0.f, 0.f};
        cur = nxt; cA = nA; cB = nB; ++ui;
        if constexpr (ALIGN_EPI) { if (wr == 1) PG8_BAR; }
    }
    PG8_WAIT_V(0);
    if constexpr (!ALIGN_EPI) { if (wr == 0) PG8_BAR; }
    PG8_BAR;
#undef PG8_SA
#undef PG8_SB
#undef PG8_STAGE
#undef PG8_LDA
#undef PG8_LDB
#undef PG8_MMA
#undef PG8_WAIT_V
#undef PG8_WAIT_L
#undef PG8_BAR
#undef PG8_SCHED
}
}

struct EpiIn {
    static constexpr bool PERM = false;
    bf16_t* QP; bf16_t* KP; bf16_t* VP; bf16_t* QS; float* XBR; bf16_t* GB; float* out; const float* rope;
    __device__ __forceinline__ void operator()(const f32x4 (&acc)[2][2][4][2], const pg8::Unit& u, int wr, int wc, int fr, int fq) const {
        const int type = u.pn >> 2, tl = u.pn & 3; const bool samp = (u.pm == 32);
        if (type <= 1) {
            const int head = 2 * tl + (wc >> 1), comp = wc & 1;
#pragma unroll
            for (int ai = 0; ai < 2; ++ai)
#pragma unroll
                for (int m = 0; m < 4; ++m) {
                    const int r = u.pm * 256 + ai * 128 + wr * 64 + m * 16 + fr;
                    int b, t, ridx; if (!samp) { b = r >> 12; t = r & 4095; ridx = t; } else { const int rs = r - MP; b = rs >> 4; t = rs & 15; ridx = 4096 + t; }
#pragma unroll
                    for (int n = 0; n < 2; ++n) {
                        const int d = 16 * n + 4 * fq;
                        const f32x4 cs = *(const f32x4*)(rope + (size_t)ridx * 64 + d), sn = *(const f32x4*)(rope + (size_t)ridx * 64 + 32 + d);
                        const f32x4 x1 = acc[ai][0][m][n], x2 = acc[ai][1][m][n];
                        f32x4 o1 = x1 * cs - x2 * sn, o2 = x2 * cs + x1 * sn;
                        if (type == 0) {
                            o1 = o1 * QSCALE; o2 = o2 * QSCALE;
                            bf16_t* dst = samp ? QS + ((size_t)(((b * 8 + head) * 2 + comp) * 16 + t)) * 64 + d : QP + ((size_t)(((b * 8 + head) * 2 + comp) * 4096 + t)) * 64 + d;
                            *(u32x2*)dst = (u32x2){cvt_pk_bf16(o1[0], o1[1]), cvt_pk_bf16(o1[2], o1[3])};
                            *(u32x2*)(dst + 32) = (u32x2){cvt_pk_bf16(o2[0], o2[1]), cvt_pk_bf16(o2[2], o2[3])};
                        } else {
                            float* ko = out + (samp ? O_KS + (size_t)(r - MP) * 1024 : O_KP + (size_t)r * 1024) + head * 128 + comp * 64 + d;
                            *(f32x4*)ko = o1; *(f32x4*)(ko + 32) = o2;
                            if (!samp) { bf16_t* dst = KP + ((size_t)(((b * 8 + head) * 2 + comp) * 4096 + t)) * 64 + d;
                                *(u32x2*)dst = (u32x2){cvt_pk_bf16(o1[0], o1[1]), cvt_pk_bf16(o1[2], o1[3])};
                                *(u32x2*)(dst + 32) = (u32x2){cvt_pk_bf16(o2[0], o2[1]), cvt_pk_bf16(o2[2], o2[3])}; }
                        }
                    }
                }
        } else {
#pragma unroll
            for (int ai = 0; ai < 2; ++ai)
#pragma unroll
                for (int m = 0; m < 4; ++m) {
                    const int r = u.pm * 256 + ai * 128 + wr * 64 + m * 16 + fr;
#pragma unroll
                    for (int bj = 0; bj < 2; ++bj)
#pragma unroll
                        for (int n = 0; n < 2; ++n) {
                            const int col = 256 * tl + 128 * bj + 32 * wc + 16 * n + 4 * fq;
                            const f32x4 v = acc[ai][bj][m][n];
                            if (type == 2) {
                                float* vo = out + (samp ? O_VS + (size_t)(r - MP) * 1024 : O_VP + (size_t)r * 1024) + col;
                                *(f32x4*)vo = v;
                                if (!samp) { const int b = r >> 12, t = r & 4095; bf16_t* dst = VP + ((size_t)((b * 8 + (col >> 7)) * 4096 + t)) * 128 + (col & 127);
                                    *(u32x2*)dst = (u32x2){cvt_pk_bf16(v[0], v[1]), cvt_pk_bf16(v[2], v[3])}; }
                            } else if (type == 3) {
                                *(f32x4*)(XBR + (size_t)r * 1024 + col) = v;
                            } else {
                                *(u32x2*)(GB + (size_t)r * 1024 + col) = (u32x2){cvt_pk_bf16(gelu_tanh(v[0]), gelu_tanh(v[1])), cvt_pk_bf16(gelu_tanh(v[2]), gelu_tanh(v[3]))};
                            }
                        }
                }
        }
    }
};
template <bool PERM_> __device__ __forceinline__ void store_partial(const f32x4 (&acc)[2][2][4][2], float* P, int ldc, const pg8::Unit& u, int wr, int wc, int fr, int fq) {
    float* p0 = P + (size_t)u.ks * 256 * ldc + (size_t)(wr * 64 + fr) * ldc + u.pn * 256 + wc * 32 + (PERM_ ? 8 * fq : 4 * fq);
#pragma unroll
    for (int ai = 0; ai < 2; ++ai)
#pragma unroll
        for (int m = 0; m < 4; ++m)
#pragma unroll
            for (int bj = 0; bj < 2; ++bj)
#pragma unroll
                for (int n = 0; n < 2; ++n) *(f32x4*)(p0 + (size_t)(ai * 128 + m * 16) * ldc + bj * 128 + (PERM_ ? 4 * n : 16 * n)) = acc[ai][bj][m][n];
}
struct EpiAxpy {
    static constexpr bool PERM = false;
    const float* base_p; float* outp; float* part;
    __device__ __forceinline__ void operator()(const f32x4 (&acc)[2][2][4][2], const pg8::Unit& u, int wr, int wc, int fr, int fq) const {
        if (u.pm == 32) { store_partial<false>(acc, part, DM, u, wr, wc, fr, fq); return; }
        const int row0 = u.pm * 256 + wr * 64 + fr, col0 = u.pn * 256 + wc * 32 + 4 * fq;
        const float* bs = base_p;
#pragma unroll
        for (int ai = 0; ai < 2; ++ai)
#pragma unroll
            for (int m = 0; m < 4; ++m) { const size_t off = (size_t)(row0 + ai * 128 + m * 16) * DM + col0;
#pragma unroll
                for (int bj = 0; bj < 2; ++bj)
#pragma unroll
                    for (int n = 0; n < 2; ++n) { const f32x4 b = *(const f32x4*)(bs + off + bj * 128 + n * 16); *(f32x4*)(outp + off + bj * 128 + n * 16) = b * DN_ALPHA + acc[ai][bj][m][n]; }
                if (m & 1) asm volatile("" ::: "memory"); }
    }
};
struct EpiUp {
    static constexpr bool PERM = true;
    bf16_t* H; float* part;
    __device__ __forceinline__ void operator()(const f32x4 (&acc)[2][2][4][2], const pg8::Unit& u, int wr, int wc, int fr, int fq) const {
        if (u.pm == 32) { store_partial<true>(acc, part, DFF, u, wr, wc, fr, fq); return; }
        const int row0 = u.pm * 256 + wr * 64 + fr, col0 = u.pn * 256 + wc * 32 + 8 * fq;
#pragma unroll
        for (int ai = 0; ai < 2; ++ai)
#pragma unroll
            for (int m = 0; m < 4; ++m) { bf16_t* rowp = H + (size_t)(row0 + ai * 128 + m * 16) * DFF + col0;
#pragma unroll
                for (int bj = 0; bj < 2; ++bj) { f32x4 v0 = acc[ai][bj][m][0], v1 = acc[ai][bj][m][1];
#pragma unroll
                    for (int j = 0; j < 4; ++j) { const float a = fmaxf(v0[j], 0.f), b = fmaxf(v1[j], 0.f); v0[j] = a * a; v1[j] = b * b; }
                    u32x4 w; w.x = cvt_pk_bf16(v0[0], v0[1]); w.y = cvt_pk_bf16(v0[2], v0[3]); w.z = cvt_pk_bf16(v1[0], v1[1]); w.w = cvt_pk_bf16(v1[2], v1[3]);
                    *(u32x4*)(rowp + bj * 128) = w; } }
    }
};

struct Args { const float* in[26]; float* out; unsigned char* ws; int ph_lo, ph_hi; };
struct Ctx {
    LAS unsigned char* lds; int tid, lane, wave, G, bid;
    const float* const* in; float* out; unsigned char* ws;
};

__device__ __forceinline__ void p0_transpose_item(const float* W, int K, int N, bf16_t* WT, LAS float* scr, int item, int lane, bool ropeperm) {
    const int nblk = N / 32, kb = item / nblk, nb = item % nblk, k0 = 64 * kb, n0 = 32 * nb;
#pragma unroll 8
    for (int i = 0; i < 32; ++i) { const int kk = 2 * i + (lane >> 5); scr[kk * 33 + (lane & 31)] = W[(size_t)(k0 + kk) * N + n0 + (lane & 31)]; }
    asm volatile("s_waitcnt lgkmcnt(0)" ::: "memory");
    int d0 = n0;
    if (ropeperm && n0 < 2048) { const int tile = n0 >> 8, c = n0 & 255, g = c >> 6, bj = (c >> 5) & 1; d0 = tile * 256 + 128 * bj + 32 * g; }
    const int c = lane & 7;
#pragma unroll
    for (int j = 0; j < 4; ++j) { const int n = (lane >> 3) + 8 * j; const LAS float* s = scr + (8 * c) * 33 + n;
        u32x4 o; o.x = cvt_pk_bf16(s[0 * 33], s[1 * 33]); o.y = cvt_pk_bf16(s[2 * 33], s[3 * 33]); o.z = cvt_pk_bf16(s[4 * 33], s[5 * 33]); o.w = cvt_pk_bf16(s[6 * 33], s[7 * 33]);
        *(u32x4*)(WT + (size_t)(d0 + n) * K + k0 + 8 * c) = o; }
    asm volatile("s_waitcnt lgkmcnt(0)" ::: "memory");
}
__device__ __forceinline__ void p0_prologue(const Ctx& C) {
    LAS float* scr = (LAS float*)(C.lds + C.wave * 16384);
    const int gw = C.bid * NWAVES + C.wave, NGW = C.G * NWAVES;
    constexpr int I_IN = (DM / 64) * (INC / 32), I_OUT = (DM / 64) * (DM / 32), I_UP = (DM / 64) * (DFF / 32), I_DN = (DFF / 64) * (DM / 32);
    constexpr int NITEMS = I_IN + I_OUT + I_UP + I_DN;
    for (int it = gw; it < NITEMS; it += NGW) {
        int r = it;
        if (r < I_IN) { p0_transpose_item(C.in[6], DM, INC, (bf16_t*)(C.ws + WS_WIN), scr, r, C.lane, true); continue; } r -= I_IN;
        if (r < I_OUT) { p0_transpose_item(C.in[19], DM, DM, (bf16_t*)(C.ws + WS_WOUT), scr, r, C.lane, false); continue; } r -= I_OUT;
        if (r < I_UP) { p0_transpose_item(C.in[22], DM, DFF, (bf16_t*)(C.ws + WS_WUP), scr, r, C.lane, false); continue; } r -= I_UP;
        p0_transpose_item(C.in[23], DFF, DM, (bf16_t*)(C.ws + WS_WDOWN), scr, r, C.lane, false);
    }
    { const size_t nth = (size_t)C.G * NTHREADS; bf16_t* XB = (bf16_t*)(C.ws + WS_XB);
      for (size_t i = (size_t)C.bid * NTHREADS + C.tid; i < (size_t)MT * DM / 8; i += nth) {
          const size_t e = i * 8; const float* src = (e < (size_t)MP * DM) ? C.in[0] + e : C.in[1] + (e - (size_t)MP * DM);
          const f32x4 a = *(const f32x4*)src, b = *(const f32x4*)(src + 4);
          u32x4 o; o.x = cvt_pk_bf16(a[0], a[1]); o.y = cvt_pk_bf16(a[2], a[3]); o.z = cvt_pk_bf16(b[0], b[1]); o.w = cvt_pk_bf16(b[2], b[3]);
          *(u32x4*)(XB + e) = o; } }
    { float* rope = (float*)(C.ws + WS_ROPE);
      for (int i = C.bid * NTHREADS + C.tid; i < 4112 * 32; i += C.G * NTHREADS) {
          const int ridx = i >> 5, k = i & 31; const int pos = ridx < 4096 ? ridx : PAST + (ridx - 4096);
          const float inv = exp2f(-(float)k * (13.287712379549449f / 32.0f));
          const float ang = (float)pos * inv;
          double rev = (double)ang * 0.15915494309189535; rev -= rint(rev);
          const float rf = (float)rev;
          rope[(size_t)ridx * 64 + k] = __builtin_amdgcn_cosf(rf); rope[(size_t)ridx * 64 + 32 + k] = __builtin_amdgcn_sinf(rf); } }
}

constexpr int AT_STAGE = 32768, AT_WSF = 65536, AT_EXCH = 0, AT_OST = 66560;
__device__ __forceinline__ s16x4 vtr(const LAS unsigned char* p) { typedef short v4i16_t __attribute__((ext_vector_type(4))); return __builtin_bit_cast(s16x4, __builtin_amdgcn_ds_read_tr16_b64_v4i16((LAS v4i16_t*)p)); }
__device__ __forceinline__ bf16x8 pack8(const f32x16& x, int s) {
    u32x4 p; p.x = cvt_pk_bf16(x[8 * s], x[8 * s + 1]); p.y = cvt_pk_bf16(x[8 * s + 2], x[8 * s + 3]); p.z = cvt_pk_bf16(x[8 * s + 4], x[8 * s + 5]); p.w = cvt_pk_bf16(x[8 * s + 6], x[8 * s + 7]);
    return __builtin_bit_cast(bf16x8, p);
}
__device__ __forceinline__ float max16(const f32x16& a) { float m = fmaxf(a[0], a[1]);
#pragma unroll
    for (int i = 2; i < 16; ++i) m = fmaxf(m, a[i]); return m; }

__device__ __forceinline__ void attn_prompt_unit(const Ctx& C, int b, int h, int qi, float lam) {
    LAS unsigned char* lds = C.lds; int lane_ = C.lane, w_ = C.wave; asm volatile("" : "+v"(lane_)); asm volatile("" : "+s"(w_));
    const int lane = lane_, w = w_, r = lane & 31, hh = lane >> 5;
    const int comp = w >> 2, rg = w & 3;
    const bf16_t* QP = (const bf16_t*)(C.ws + WS_QP); const bf16_t* KP = (const bf16_t*)(C.ws + WS_KP); const bf16_t* VP = (const bf16_t*)(C.ws + WS_VP);
    const int NT = 2 * qi + 2, my_nt = 2 * qi + 1 + (rg >> 1);
    bf16x8 qf[4];
    { const bf16_t* qs = QP + ((size_t)(((b * 8 + h) * 2 + comp) * 4096 + 128 * qi + 32 * rg + r)) * 64 + 8 * hh;
#pragma unroll
      for (int s = 0; s < 4; ++s) qf[s] = *(const bf16x8*)(qs + 16 * s); }
    const int krow_ = 8 * w + (lane >> 3), kcp = lane & 7, klc = kcp ^ ((krow_ >> 1) & 7);
    const bf16_t* k1src = KP + ((size_t)(((b * 8 + h) * 2 + 0) * 4096 + krow_)) * 64 + klc * 8;
    const bf16_t* k2src = KP + ((size_t)(((b * 8 + h) * 2 + 1) * 4096 + krow_)) * 64 + klc * 8;
    const bf16_t* vsrc0; const bf16_t* vsrc1;
    { const int q0 = 2 * w, q1 = 2 * w + 1;
      vsrc0 = VP + ((size_t)((b * 8 + h) * 4096 + 16 * (q0 & 3) + (lane >> 2))) * 128 + (q0 >> 2) * 32 + (lane & 3) * 8;
      vsrc1 = VP + ((size_t)((b * 8 + h) * 4096 + 16 * (q1 & 3) + (lane >> 2))) * 128 + (q1 >> 2) * 32 + (lane & 3) * 8; }
    const unsigned wl = (unsigned)w * 1024u;
#define AT_ISSUE(jt, st) do { \
        __builtin_amdgcn_global_load_lds((const unsigned*)(k1src + (size_t)(jt) * 64 * 64), (LAS unsigned*)(lds + (st) * AT_STAGE + wl), 16, 0, 0); \
        __builtin_amdgcn_global_load_lds((const unsigned*)(k2src + (size_t)(jt) * 64 * 64), (LAS unsigned*)(lds + (st) * AT_STAGE + 8192 + wl), 16, 0, 0); \
        __builtin_amdgcn_global_load_lds((const unsigned*)(vsrc0 + (size_t)(jt) * 64 * 128), (LAS unsigned*)(lds + (st) * AT_STAGE + 16384 + 2 * wl), 16, 0, 0); \
        __builtin_amdgcn_global_load_lds((const unsigned*)(vsrc1 + (size_t)(jt) * 64 * 128), (LAS unsigned*)(lds + (st) * AT_STAGE + 16384 + 2 * wl + 1024), 16, 0, 0); } while (0)
    LAS float* wsf = (LAS float*)(lds + AT_WSF) + w * 32;
    f32x16 o[4];
#pragma unroll
    for (int d = 0; d < 4; ++d)
#pragma unroll
        for (int i = 0; i < 16; ++i) o[d][i] = 0.f;
    float m_run = -1e30f, l_run = 0.f;
    const int kro = r * 128, ksw = (r >> 1) & 7;
    const int i16 = lane & 15, blk = (lane >> 4) & 1;
    const int vro = (4 * hh + (i16 >> 2)) * 64 + 32 * blk + 8 * (i16 & 3);
    AT_ISSUE(0, 0);
    for (int jt = 0; jt < NT; ++jt) {
        const int st = jt & 1;
        if (jt + 1 < NT) { AT_ISSUE(jt + 1, st ^ 1); asm volatile("s_waitcnt vmcnt(4)" ::: "memory"); }
        else asm volatile("s_waitcnt vmcnt(0)" ::: "memory");
        __builtin_amdgcn_s_barrier();
        asm volatile("" ::: "memory");
        if (jt < my_nt) {
            const LAS unsigned char* kb = lds + st * AT_STAGE + comp * 8192 + kro;
            const LAS unsigned char* vb = lds + st * AT_STAGE + 16384 + vro;
            f32x16 s0, s1;
#pragma unroll
            for (int i = 0; i < 16; ++i) { s0[i] = 0.f; s1[i] = 0.f; }
#pragma unroll
            for (int s = 0; s < 4; ++s) {
                const int co = ((2 * s + hh) ^ ksw) * 16;
                const bf16x8 k0 = *(const LAS bf16x8*)(kb + co), k1 = *(const LAS bf16x8*)(kb + 32 * 128 + co);
                s0 = MFMA32(k0, qf[s], s0); s1 = MFMA32(k1, qf[s], s1);
            }
            float mx = fmaxf(max16(s0), max16(s1));
            mx = fmaxf(mx, __shfl_xor(mx, 32));
            const float mnew = fmaxf(m_run, mx), alpha = fast_exp2(m_run - mnew);
            m_run = mnew;
            float ls = 0.f;
#pragma unroll
            for (int i = 0; i < 16; ++i) { s0[i] = fast_exp2(s0[i] - mnew); s1[i] = fast_exp2(s1[i] - mnew); ls += s0[i] + s1[i]; }
            l_run = l_run * alpha + ls;
            if (hh == 0) wsf[r] = alpha;
            asm volatile("s_waitcnt lgkmcnt(0)" ::: "memory");
#pragma unroll
            for (int i = 0; i < 16; ++i) { const float a = wsf[crow(i, hh)];
#pragma unroll
                for (int d = 0; d < 4; ++d) o[d][i] *= a; }
            bf16x8 pa[4]; pa[0] = pack8(s0, 0); pa[1] = pack8(s0, 1); pa[2] = pack8(s1, 0); pa[3] = pack8(s1, 1);
#pragma unroll
            for (int ks = 0; ks < 4; ++ks) {
#pragma unroll
                for (int d = 0; d < 4; ++d) {
                    const s16x4 lo = vtr(vb + d * 4096 + ks * 1024), hi = vtr(vb + d * 4096 + ks * 1024 + 512);
                    const bf16x8 vf = __builtin_shufflevector(lo, hi, 0, 1, 2, 3, 4, 5, 6, 7);
                    o[d] = MFMA32(pa[ks], vf, o[d]);
                }
            }
        }
        asm volatile("s_waitcnt lgkmcnt(0)" ::: "memory");
        __builtin_amdgcn_s_barrier();
        asm volatile("" ::: "memory");
    }
#undef AT_ISSUE
    { float lt = l_run + __shfl_xor(l_run, 32); const float inv = fast_rcp(lt) * (comp ? lam : 1.0f);
      if (hh == 0) wsf[r] = inv;
      asm volatile("s_waitcnt lgkmcnt(0)" ::: "memory");
      float iv[16];
#pragma unroll
      for (int i = 0; i < 16; ++i) iv[i] = wsf[crow(i, hh)];
      LAS float* ex = (LAS float*)(lds + AT_EXCH) + rg * 4096;
      if (comp == 1) {
#pragma unroll
          for (int d = 0; d < 4; ++d)
#pragma unroll
              for (int i = 0; i < 16; ++i) ex[crow(i, hh) * 128 + d * 32 + r] = o[d][i] * iv[i];
      }
      asm volatile("s_waitcnt lgkmcnt(0)" ::: "memory");
      __builtin_amdgcn_s_barrier();
      asm volatile("" ::: "memory");
      if (comp == 0) {
          const float* sg = C.in[11]; float gsc[4];
#pragma unroll
          for (int d = 0; d < 4; ++d) gsc[d] = sg[d * 32 + r] * (1.0f - LAM_INIT);
          LAS unsigned short* ost = (LAS unsigned short*)(lds + AT_OST) + rg * 4096;
#pragma unroll
          for (int i = 0; i < 16; ++i) { const int q = crow(i, hh); float v[4], ss = 0.f;
#pragma unroll
              for (int d = 0; d < 4; ++d) { v[d] = o[d][i] * iv[i] - ex[q * 128 + d * 32 + r]; ss += v[d] * v[d]; }
              ss += __shfl_xor(ss, 1); ss += __shfl_xor(ss, 2); ss += __shfl_xor(ss, 4); ss += __shfl_xor(ss, 8); ss += __shfl_xor(ss, 16);
              const float rstd = rsqrtf(ss * (1.0f / 128.0f) + RMS_EPS);
#pragma unroll
              for (int d = 0; d < 4; ++d) ost[q * 128 + d * 32 + r] = f2bf(v[d] * rstd * gsc[d]); }
          asm volatile("s_waitcnt lgkmcnt(0)" ::: "memory");
          bf16_t* cat = (bf16_t*)(C.ws + WS_CAT) + ((size_t)(b * 4096 + 128 * qi + 32 * rg + (lane >> 4))) * DM + h * 128 + (lane & 15) * 8;
#pragma unroll
          for (int k = 0; k < 8; ++k) *(u32x4*)(cat + (size_t)(4 * k) * DM) = *(const LAS u32x4*)(ost + ((lane >> 4) + 4 * k) * 128 + (lane & 15) * 8);
      }
      asm volatile("s_waitcnt lgkmcnt(0)" ::: "memory");
      __builtin_amdgcn_s_barrier();
      asm volatile("" ::: "memory");
    }
}

constexpr int SA_O = 0, SA_ML = 131072, SA_WSF = 131072 + 2048, SA_QH = 131072 + 4096;
__device__ __forceinline__ void attn_sample_unit(const Ctx& C, int b, int h, float lam) {
    LAS unsigned char* lds = C.lds; int lane_ = C.lane, w_ = C.wave; asm volatile("" : "+v"(lane_)); asm volatile("" : "+s"(w_));
    const int lane = lane_, w = w_, r = lane & 31, hh = lane >> 5;
    const bf16_t* QS = (const bf16_t*)(C.ws + WS_QS);
    { const int s = w; bf16x8 q;
#pragma unroll
      for (int j = 0; j < 8; ++j) q[j] = 0;
      const int cq = (s < 4) ? 0 : 1; const bool act = cq ? (r >= 16) : (r < 16);
      if (act) q = *(const bf16x8*)(QS + ((size_t)(((b * 8 + h) * 2 + cq) * 16 + (r & 15))) * 64 + 16 * (s & 3) + 8 * hh);
      *(LAS bf16x8*)(lds + SA_QH + s * 1024 + lane * 16) = q; }
    asm volatile("s_waitcnt lgkmcnt(0)" ::: "memory");
    __builtin_amdgcn_s_barrier();
    asm volatile("" ::: "memory");
    LAS float* wsf = (LAS float*)(lds + SA_WSF) + w * 32;
    f32x16 o[4];
#pragma unroll
    for (int d = 0; d < 4; ++d)
#pragma unroll
        for (int i = 0; i < 16; ++i) o[d][i] = 0.f;
    float m_run = -1e30f, l_run = 0.f;
    const float* ck = C.in[2] + (size_t)b * PAST * 1024 + h * 128; const float* cv = C.in[3] + (size_t)b * PAST * 1024 + h * 128;
    const float* nk = C.out + O_KS + (size_t)b * 16 * 1024 + h * 128; const float* nv = C.out + O_VS + (size_t)b * 16 * 1024 + h * 128;
#pragma unroll 1
    for (int tile = w; tile < 65; tile += 8) {
        const bool isnew = (tile == 64);
        const float* kbase = isnew ? nk : ck + (size_t)tile * 32 * 1024; const float* vbase = isnew ? nv : cv + (size_t)tile * 32 * 1024;
        const int rk = isnew ? (r & 15) : r;
        f32x16 sc;
#pragma unroll
        for (int i = 0; i < 16; ++i) sc[i] = 0.f;
        const float* kp = kbase + (size_t)rk * 1024 + 8 * hh;
#pragma unroll
        for (int s = 0; s < 8; ++s) {
            const f32x4 a = *(const f32x4*)(kp + 16 * s), c = *(const f32x4*)(kp + 16 * s + 4);
            u32x4 p; p.x = cvt_pk_bf16(a[0], a[1]); p.y = cvt_pk_bf16(a[2], a[3]); p.z = cvt_pk_bf16(c[0], c[1]); p.w = cvt_pk_bf16(c[2], c[3]);
            const bf16x8 qh = *(const LAS bf16x8*)(lds + SA_QH + s * 1024 + lane * 16);
            sc = MFMA32(__builtin_bit_cast(bf16x8, p), qh, sc);
        }
        if (isnew) {
#pragma unroll
            for (int i = 0; i < 16; ++i) if (crow(i, hh) >= 16) sc[i] = -1e30f;
        }
        float mx = max16(sc); mx = fmaxf(mx, __shfl_xor(mx, 32));
        const float mnew = fmaxf(m_run, mx), alpha = fast_exp2(m_run - mnew);
        m_run = mnew;
        float ls = 0.f;
#pragma unroll
        for (int i = 0; i < 16; ++i) { sc[i] = fast_exp2(sc[i] - mnew); ls += sc[i]; }
        l_run = l_run * alpha + ls;
        if (hh == 0) wsf[r] = alpha;
        asm volatile("s_waitcnt lgkmcnt(0)" ::: "memory");
#pragma unroll
        for (int i = 0; i < 16; ++i) { const float a = wsf[crow(i, hh)];
#pragma unroll
            for (int d = 0; d < 4; ++d) o[d][i] *= a; }
        bf16x8 pa[2]; pa[0] = pack8(sc, 0); pa[1] = pack8(sc, 1);
#pragma unroll
        for (int s = 0; s < 2; ++s) {
#pragma unroll
            for (int d = 0; d < 4; ++d) {
                float v[8];
#pragma unroll
                for (int j = 0; j < 8; ++j) { int key = 16 * s + 8 * (j >> 2) + 4 * hh + (j & 3); if (isnew) key &= 15; v[j] = vbase[(size_t)key * 1024 + d * 32 + r]; }
                u32x4 p; p.x = cvt_pk_bf16(v[0], v[1]); p.y = cvt_pk_bf16(v[2], v[3]); p.z = cvt_pk_bf16(v[4], v[5]); p.w = cvt_pk_bf16(v[6], v[7]);
                o[d] = MFMA32(pa[s], __builtin_bit_cast(bf16x8, p), o[d]);
            }
        }
    }
    { float lt = l_run + __shfl_xor(l_run, 32);
      LAS float* ml = (LAS float*)(lds + SA_ML) + w * 64;
      if (hh == 0) { ml[r] = m_run; ml[32 + r] = lt; }
      LAS float* op = (LAS float*)(lds + SA_O) + w * 4096;
#pragma unroll
      for (int d = 0; d < 4; ++d)
#pragma unroll
          for (int i = 0; i < 16; ++i) op[crow(i, hh) * 128 + d * 32 + r] = o[d][i]; }
    asm volatile("s_waitcnt lgkmcnt(0)" ::: "memory");
    __builtin_amdgcn_s_barrier();
    asm volatile("" ::: "memory");
    { const float* sg = C.in[11];
#pragma unroll
      for (int e = 0; e < 2; ++e) {
          const int t = 2 * w + e; float res[2][2];
#pragma unroll
          for (int c = 0; c < 2; ++c) {
              const int col = c * 16 + t; float M = -1e30f;
#pragma unroll
              for (int ww = 0; ww < 8; ++ww) M = fmaxf(M, ((LAS float*)(lds + SA_ML))[ww * 64 + col]);
              float L = 0.f, a0 = 0.f, a1 = 0.f;
#pragma unroll
              for (int ww = 0; ww < 8; ++ww) { const float sc = fast_exp2(((LAS float*)(lds + SA_ML))[ww * 64 + col] - M); L += ((LAS float*)(lds + SA_ML))[ww * 64 + 32 + col] * sc;
                  const LAS float* op = (LAS float*)(lds + SA_O) + ww * 4096 + col * 128; a0 += op[lane] * sc; a1 += op[64 + lane] * sc; }
              const float il = fast_rcp(L); res[c][0] = a0 * il; res[c][1] = a1 * il;
          }
          const float v0 = res[0][0] - lam * res[1][0], v1 = res[0][1] - lam * res[1][1];
          const float ss = wave_sum(v0 * v0 + v1 * v1);
          const float rstd = rsqrtf(ss * (1.0f / 128.0f) + RMS_EPS);
          bf16_t* cat = (bf16_t*)(C.ws + WS_CAT) + ((size_t)(MP + b * 16 + t)) * DM + h * 128;
          cat[lane] = f2bf(v0 * rstd * sg[lane] * (1.0f - LAM_INIT)); cat[64 + lane] = f2bf(v1 * rstd * sg[64 + lane] * (1.0f - LAM_INIT));
      } }
    asm volatile("s_waitcnt lgkmcnt(0)" ::: "memory");
    __builtin_amdgcn_s_barrier();
    asm volatile("" ::: "memory");
}

constexpr int LR_WF = 0, LR_XS = 16384, LR_XS_W = 9728, LR_XC = LR_XS + 8 * LR_XS_W, LR_COMP = LR_XC + 8 * 4096;
template <bool SAMPLE> __device__ __forceinline__ void lru_unit(const Ctx& C, int b, int cb) {
    LAS unsigned char* lds = C.lds; int lane_ = C.lane, w_ = C.wave; asm volatile("" : "+v"(lane_)); asm volatile("" : "+s"(w_));
    const int lane = lane_, w = w_, tid = w * 64 + lane, j = lane & 31, hh = lane >> 5;
    const float* XBR = (const float*)(C.ws + WS_XBR); const bf16_t* GB = (const bf16_t*)(C.ws + WS_GB); bf16_t* CAT = (bf16_t*)(C.ws + WS_CAT);
    for (int e = tid; e < 1024; e += NTHREADS) {
        const int l = e & 63, s = (e >> 6) & 3, nb = (e >> 8) & 1, gate = e >> 9; const int jj0 = 16 * s + 8 * (l >> 5), col = 32 * nb + (l & 31);
        const float* Wg = (gate ? C.in[16] : C.in[14]) + (size_t)cb * 4096;
        float v[8];
#pragma unroll
        for (int q = 0; q < 8; ++q) v[q] = Wg[(jj0 + q) * 64 + col];
        u32x4 p; p.x = cvt_pk_bf16(v[0], v[1]); p.y = cvt_pk_bf16(v[2], v[3]); p.z = cvt_pk_bf16(v[4], v[5]); p.w = cvt_pk_bf16(v[6], v[7]);
        *(LAS u32x4*)(lds + LR_WF + e * 16) = p;
    }
    float cw[2][4], cbias[2], ba[2], bi[2], spl[2];
#pragma unroll
    for (int nb = 0; nb < 2; ++nb) { const int ch = cb * 64 + 32 * nb + j;
#pragma unroll
        for (int q = 0; q < 4; ++q) cw[nb][q] = C.in[12][q * 1024 + ch];
        cbias[nb] = C.in[13][ch]; ba[nb] = C.in[15][ch]; bi[nb] = C.in[17][ch];
        const float L = C.in[18][ch]; const float sp = (L < -15.f) ? -L : log1pf(expf(-L));
        spl[nb] = 8.0f * sp * LOG2E; }
    asm volatile("s_waitcnt lgkmcnt(0)" ::: "memory");
    __builtin_amdgcn_s_barrier();
    asm volatile("" ::: "memory");
    LAS float* XS = (LAS float*)(lds + LR_XS + w * LR_XS_W);
    LAS unsigned char* XC = lds + LR_XC + w * 4096;
    float carry[2] = {0.f, 0.f};
    const int NR = SAMPLE ? 1 : 16;
#pragma unroll 1
    for (int rr = 0; rr < NR; ++rr) {
        const int t0 = rr * 256 + w * 32;
        if constexpr (!SAMPLE) {
#pragma unroll 1
            for (int idx = lane; idx < 35 * 16; idx += 64) { const int row = idx >> 4, c4 = idx & 15, tt = t0 - 3 + row;
                f32x4 v = (f32x4){0.f, 0.f, 0.f, 0.f}; if (tt >= 0) v = *(const f32x4*)(XBR + ((size_t)(b * 4096 + tt)) * 1024 + cb * 64 + c4 * 4);
                *(LAS f32x4*)(XS + row * 64 + c4 * 4) = v; }
        } else {
#pragma unroll 1
            for (int idx = lane; idx < 38 * 16; idx += 64) { const int row = idx >> 4, c4 = idx & 15, bl = row >= 19 ? 1 : 0, k = row - 19 * bl, bb = 2 * w + bl;
                const float* src = (k < 3) ? C.in[5] + ((size_t)(bb * 3 + k)) * 1024 + cb * 64 + c4 * 4 : XBR + ((size_t)(MP + bb * 16 + (k - 3))) * 1024 + cb * 64 + c4 * 4;
                *(LAS f32x4*)(XS + row * 64 + c4 * 4) = *(const f32x4*)src; }
        }
        asm volatile("s_waitcnt lgkmcnt(0)" ::: "memory");
        float xc[2][16];
#pragma unroll
        for (int nb = 0; nb < 2; ++nb)
#pragma unroll
            for (int g = 0; g < 4; ++g) {
                int tb = 8 * g + 4 * hh; if constexpr (SAMPLE) tb = (g >> 1) * 19 + 8 * (g & 1) + 4 * hh;
                float x[7];
#pragma unroll
                for (int k = 0; k < 7; ++k) x[k] = XS[(tb + k) * 64 + 32 * nb + j];
#pragma unroll
                for (int i = 0; i < 4; ++i) xc[nb][4 * g + i] = cbias[nb] + cw[nb][0] * x[i] + cw[nb][1] * x[i + 1] + cw[nb][2] * x[i + 2] + cw[nb][3] * x[i + 3];
            }
#pragma unroll
        for (int nb = 0; nb < 2; ++nb)
#pragma unroll
            for (int q = 0; q < 16; ++q) { const int row = crow(q, hh), ch = 32 * nb + j;
                *(LAS unsigned short*)(XC + row * 128 + (((ch >> 3) ^ ((row >> 1) & 7)) * 16) + (ch & 7) * 2) = f2bf(xc[nb][q]); }
        asm volatile("s_waitcnt lgkmcnt(0)" ::: "memory");
        bf16x8 xa[4];
#pragma unroll
        for (int s = 0; s < 4; ++s) xa[s] = *(const LAS bf16x8*)(XC + j * 128 + (((2 * s + hh) ^ ((j >> 1) & 7)) * 16));
        float av[2][16], uv[2][16];
#pragma unroll
        for (int nb = 0; nb < 2; ++nb) {
            f32x16 acc;
#pragma unroll
            for (int i = 0; i < 16; ++i) acc[i] = 0.f;
#pragma unroll
            for (int s = 0; s < 4; ++s) acc = MFMA32(xa[s], *(const LAS bf16x8*)(lds + LR_WF + ((0 * 2 + nb) * 4 + s) * 1024 + lane * 16), acc);
#pragma unroll
            for (int i = 0; i < 16; ++i) { const float rg = sigmoidf_(acc[i] + ba[nb]); av[nb][i] = fast_exp2(-rg * spl[nb]); }
#pragma unroll
            for (int i = 0; i < 16; ++i) acc[i] = 0.f;
#pragma unroll
            for (int s = 0; s < 4; ++s) acc = MFMA32(xa[s], *(const LAS bf16x8*)(lds + LR_WF + ((1 * 2 + nb) * 4 + s) * 1024 + lane * 16), acc);
#pragma unroll
            for (int i = 0; i < 16; ++i) { const float ig = sigmoidf_(acc[i] + bi[nb]); const float a = av[nb][i];
                uv[nb][i] = sqrtf(fmaxf(1.0f - a * a, 0.f)) * ig * xc[nb][i]; }
        }
        float Hc[2], Pc[2];
#pragma unroll
        for (int nb = 0; nb < 2; ++nb) {
            Hc[nb] = 0.f; Pc[nb] = 1.f;
#pragma unroll
            for (int g = 0; g < 4; ++g) {
#pragma unroll
                for (int i = 1; i < 4; ++i) { uv[nb][4 * g + i] = av[nb][4 * g + i] * uv[nb][4 * g + i - 1] + uv[nb][4 * g + i]; av[nb][4 * g + i] = av[nb][4 * g + i] * av[nb][4 * g + i - 1]; }
                if (SAMPLE && g == 2) { Hc[nb] = 0.f; Pc[nb] = 1.f; }
                float nH = uv[nb][4 * g + 3] + av[nb][4 * g + 3] * Hc[nb], nP = av[nb][4 * g + 3] * Pc[nb];
                const float rH = __shfl_xor(nH, 32), rP = __shfl_xor(nP, 32);
                if (hh == 1) { Hc[nb] = rH; Pc[nb] = rP; }
                const float l3h = uv[nb][4 * g + 3], l3p = av[nb][4 * g + 3];
#pragma unroll
                for (int i = 0; i < 4; ++i) { uv[nb][4 * g + i] = uv[nb][4 * g + i] + av[nb][4 * g + i] * Hc[nb]; av[nb][4 * g + i] = av[nb][4 * g + i] * Pc[nb]; }
                nH = l3h + l3p * Hc[nb]; nP = l3p * Pc[nb];
                const float r2H = __shfl_xor(nH, 32), r2P = __shfl_xor(nP, 32);
                if (hh == 0) { Hc[nb] = r2H; Pc[nb] = r2P; } else { Hc[nb] = nH; Pc[nb] = nP; }
            }
        }
        float cin[2][2];
        if constexpr (!SAMPLE) {
            LAS float* CP = (LAS float*)(lds + LR_COMP) + (rr & 1) * 1024;
            if (hh == 1) {
#pragma unroll
                for (int nb = 0; nb < 2; ++nb) { CP[(w * 64 + 32 * nb + j) * 2] = Pc[nb]; CP[(w * 64 + 32 * nb + j) * 2 + 1] = Hc[nb]; } }
            asm volatile("s_waitcnt lgkmcnt(0)" ::: "memory");
            __builtin_amdgcn_s_barrier();
            asm volatile("" ::: "memory");
#pragma unroll
            for (int nb = 0; nb < 2; ++nb) { float c = carry[nb]; cin[nb][0] = c;
#pragma unroll
                for (int ww = 0; ww < 8; ++ww) { if (ww == w) cin[nb][0] = c; const f32x2 ph = *(const LAS f32x2*)(CP + (ww * 64 + 32 * nb + j) * 2); c = ph.x * c + ph.y; }
                carry[nb] = c; cin[nb][1] = cin[nb][0]; }
        } else {
#pragma unroll
            for (int nb = 0; nb < 2; ++nb) { cin[nb][0] = C.in[4][(size_t)(2 * w) * 1024 + cb * 64 + 32 * nb + j]; cin[nb][1] = C.in[4][(size_t)(2 * w + 1) * 1024 + cb * 64 + 32 * nb + j]; }
        }
        LAS float* HT = XS;
#pragma unroll
        for (int nb = 0; nb < 2; ++nb)
#pragma unroll
            for (int q = 0; q < 16; ++q) {
                const int rho = crow(q, hh); const float hval = uv[nb][q] + av[nb][q] * cin[nb][SAMPLE ? (q >> 3) : 0];
                HT[rho * 64 + 32 * nb + j] = hval;
            }
        asm volatile("s_waitcnt lgkmcnt(0)" ::: "memory");
        {
            const int rho = lane >> 1, c0 = (lane & 1) * 32;
            size_t row; if constexpr (!SAMPLE) row = (size_t)(b * 4096 + t0 + rho); else row = (size_t)(MP + (2 * w + (rho >> 4)) * 16 + (rho & 15));
            const bf16_t* gp = GB + row * 1024 + cb * 64 + c0; bf16_t* op = CAT + row * DM + 1024 + cb * 64 + c0;
            const LAS float* hp = HT + rho * 64 + c0;
#pragma unroll
            for (int k = 0; k < 4; ++k) {
                const u32x4 gv = *(const u32x4*)(gp + 8 * k); const f32x4 h0 = *(const LAS f32x4*)(hp + 8 * k), h1 = *(const LAS f32x4*)(hp + 8 * k + 4);
                u32x4 ov;
                ov.x = cvt_pk_bf16(h0[0] * __uint_as_float(gv.x << 16), h0[1] * __uint_as_float(gv.x & 0xffff0000u));
                ov.y = cvt_pk_bf16(h0[2] * __uint_as_float(gv.y << 16), h0[3] * __uint_as_float(gv.y & 0xffff0000u));
                ov.z = cvt_pk_bf16(h1[0] * __uint_as_float(gv.z << 16), h1[1] * __uint_as_float(gv.z & 0xffff0000u));
                ov.w = cvt_pk_bf16(h1[2] * __uint_as_float(gv.w << 16), h1[3] * __uint_as_float(gv.w & 0xffff0000u));
                *(u32x4*)(op + 8 * k) = ov;
            }
            if constexpr (SAMPLE) { if ((rho & 15) == 15) { float* hs = C.out + O_HS + (size_t)(2 * w + (rho >> 4)) * 1024 + cb * 64 + c0;
#pragma unroll
                for (int k = 0; k < 8; ++k) *(f32x4*)(hs + 4 * k) = *(const LAS f32x4*)(hp + 4 * k); } }
        }
        asm volatile("s_waitcnt lgkmcnt(0)" ::: "memory");
    }
    if constexpr (!SAMPLE) {
        if (w == 0 && hh == 0) {
#pragma unroll
            for (int nb = 0; nb < 2; ++nb) C.out[O_HP + (size_t)b * 1024 + cb * 64 + 32 * nb + j] = carry[nb]; }
        if (tid < 192) { const int k = tid >> 6, ch = cb * 64 + (tid & 63); C.out[O_CP + (size_t)(b * 3 + k) * 1024 + ch] = XBR[((size_t)(b * 4096 + 4093 + k)) * 1024 + ch]; }
    } else {
        for (int e = tid; e < 16 * 3 * 64; e += NTHREADS) { const int ch = cb * 64 + (e & 63), k = (e >> 6) % 3, bb = e / 192;
            C.out[O_CS + (size_t)(bb * 3 + k) * 1024 + ch] = XBR[((size_t)(MP + bb * 16 + 13 + k)) * 1024 + ch]; }
    }
    asm volatile("s_waitcnt lgkmcnt(0)" ::: "memory");
    __builtin_amdgcn_s_barrier();
    asm volatile("" ::: "memory");
}

__device__ __forceinline__ void ln_rows(const Ctx& C, const float* src, float* dstf, bf16_t* dstb, const float* g, const float* bta, const float* base_s, const float* part, int nks) {
    const int gw = C.bid * NWAVES + C.wave, NGW = C.G * NWAVES, lane = C.lane;
    for (int mm = gw; mm < MT; mm += NGW) {
        const int m = MT - 1 - mm;
        f32x4 v[8]; float s = 0.f;
        if (m < MP) { const f32x4* xr = (const f32x4*)(src + (size_t)m * DM) + lane;
#pragma unroll
            for (int k = 0; k < 8; ++k) v[k] = xr[64 * k];
        } else { const f32x4* xr = (const f32x4*)(base_s + (size_t)(m - MP) * DM) + lane;
#pragma unroll
            for (int k = 0; k < 8; ++k) v[k] = xr[64 * k] * DN_ALPHA;
#pragma unroll 2
            for (int ks = 0; ks < nks; ++ks) { const f32x4* pr = (const f32x4*)(part + ((size_t)ks * 256 + (m - MP)) * DM) + lane;
#pragma unroll
                for (int k = 0; k < 8; ++k) v[k] += pr[64 * k]; } }
#pragma unroll
        for (int k = 0; k < 8; ++k) s += (v[k][0] + v[k][1]) + (v[k][2] + v[k][3]);
        const float mean = wave_sum(s) * (1.0f / DM); float s2 = 0.f;
#pragma unroll
        for (int k = 0; k < 8; ++k) { v[k] = v[k] - mean; s2 += (v[k][0] * v[k][0] + v[k][1] * v[k][1]) + (v[k][2] * v[k][2] + v[k][3] * v[k][3]); }
        const float rstd = rsqrtf(wave_sum(s2) * (1.0f / DM) + LN_EPS);
#pragma unroll
        for (int k = 0; k < 8; ++k) {
            const f32x4 gg = ((const f32x4*)g)[64 * k + lane], bb = ((const f32x4*)bta)[64 * k + lane];
            const f32x4 y = v[k] * rstd * gg + bb;
            ((f32x4*)(dstf + (size_t)m * DM))[64 * k + lane] = y;
            if (dstb) *(u32x2*)(dstb + (size_t)m * DM + (64 * k + lane) * 4) = (u32x2){cvt_pk_bf16(y[0], y[1]), cvt_pk_bf16(y[2], y[3])};
        }
    }
}
__device__ __forceinline__ void reduce_up_sample(const Ctx& C) {
    const float* part = (const float*)(C.ws + WS_PART5); bf16_t* H = (bf16_t*)(C.ws + WS_H);
    for (int r = C.bid; r < MS; r += C.G) {
#pragma unroll
        for (int h2 = 0; h2 < 2; ++h2) {
            const int col = h2 * 4096 + C.tid * 8; f32x4 a = (f32x4){0.f, 0.f, 0.f, 0.f}, b = a;
#pragma unroll
            for (int ks = 0; ks < KS5; ++ks) { const float* p = part + ((size_t)ks * 256 + r) * DFF + col; a += *(const f32x4*)p; b += *(const f32x4*)(p + 4); }
#pragma unroll
            for (int jx = 0; jx < 4; ++jx) { const float x = fmaxf(a[jx], 0.f), y = fmaxf(b[jx], 0.f); a[jx] = x * x; b[jx] = y * y; }
            u32x4 w; w.x = cvt_pk_bf16(a[0], a[1]); w.y = cvt_pk_bf16(a[2], a[3]); w.z = cvt_pk_bf16(b[0], b[1]); w.w = cvt_pk_bf16(b[2], b[3]);
            *(u32x4*)(H + (size_t)(MP + r) * DFF + col) = w;
        }
    }
}

#define XB_TMO      128
#define XB_XCNT(j)  (256  + 64 * (j))
#define XB_XSUB(j)  (1280 + 64 * (j))
#define XB_XGEN(j)  (2304 + 64 * (j))
#define XB_TOP      3328
#define XB_TOPGEN   3392
#define XCD_BAR_WORDS 3456
#define XB_SPIN_CAP (1u << 18)
__device__ __forceinline__ unsigned xb_ld(unsigned* p)              { return __hip_atomic_load(p, __ATOMIC_RELAXED, __HIP_MEMORY_SCOPE_AGENT); }
__device__ __forceinline__ unsigned xb_add(unsigned* p, unsigned v) { return __hip_atomic_fetch_add(p, v, __ATOMIC_RELAXED, __HIP_MEMORY_SCOPE_AGENT); }
__device__ __forceinline__ unsigned xb_xcc_id() { return (unsigned)__builtin_amdgcn_s_getreg((3 << 11) | 20) & 0xFu; }
#define XB_SPIN(cond, bar) do { unsigned _sp = 0; while (cond) { __builtin_amdgcn_s_sleep(1); \
    if ((++_sp & 255u) == 0u) { if (xb_ld(&(bar)[XB_TMO])) break; if (_sp > XB_SPIN_CAP) { atomicAdd(&(bar)[XB_TMO], 1u); break; } } } } while (0)
struct XcdBarrier { unsigned* bar; unsigned x; volatile LAS unsigned* st; };
__device__ __forceinline__ XcdBarrier xcd_barrier_post(unsigned* bar, volatile LAS unsigned* st) {
    XcdBarrier b; b.bar = bar; b.x = xb_xcc_id(); b.st = st;
    if (threadIdx.x == 0) (void)xb_add(&bar[XB_XCNT(b.x)], 1u);
    return b;
}
__device__ __forceinline__ void xcd_barrier_complete(unsigned* bar, unsigned x, unsigned& nloc, unsigned& nx) {
    const unsigned G = gridDim.x * gridDim.y * gridDim.z;
    unsigned sum, cnt, mine, sp = 0u;
    for (;;) {
        sum = 0u; cnt = 0u; mine = 0u;
#pragma unroll
        for (unsigned j = 0; j < 16; ++j) { const unsigned c = xb_ld(&bar[XB_XCNT(j)]); sum += c; cnt += (c > 0u) ? 1u : 0u; mine = (j == x) ? c : mine; }
        if (sum == G) break;
        __builtin_amdgcn_s_sleep(1);
        if ((++sp & 255u) == 0u) { if (xb_ld(&bar[XB_TMO])) break; if (sp > XB_SPIN_CAP) { atomicAdd(&bar[XB_TMO], 1u); break; } }
    }
    nloc = mine > 0u ? mine : 1u; nx = cnt > 0u ? cnt : 1u;
}
__device__ __forceinline__ void xcd_barrier(const XcdBarrier& b) {
    asm volatile("s_waitcnt vmcnt(0)" ::: "memory");
    __syncthreads();
    if (threadIdx.x == 0) {
        unsigned* bar = b.bar;
        __builtin_amdgcn_s_waitcnt(0);
        unsigned nloc = b.st[0], nx = b.st[1];
        if (nloc == 0u) { xcd_barrier_complete(bar, b.x, nloc, nx); b.st[0] = nloc; b.st[1] = nx; }
        const unsigned old = xb_add(&bar[XB_XSUB(b.x)], 1u);
        const unsigned gen = old / nloc;
        if (old + 1u == (gen + 1u) * nloc) {
            __builtin_amdgcn_fence(__ATOMIC_RELEASE, "agent");
            asm volatile("s_waitcnt vmcnt(0)" ::: "memory");
            const unsigned og = xb_add(&bar[XB_TOP], 1u);
            const unsigned tg = og / nx;
            if (og + 1u == (tg + 1u) * nx) xb_add(&bar[XB_TOPGEN], 1u);
            else XB_SPIN(xb_ld(&bar[XB_TOPGEN]) == tg, bar);
            __builtin_amdgcn_fence(__ATOMIC_ACQUIRE, "agent");
            xb_add(&bar[XB_XGEN(b.x)], 1u);
            asm volatile("s_waitcnt vmcnt(0)" ::: "memory");
        } else {
            XB_SPIN(xb_ld(&bar[XB_XGEN(b.x)]) == gen, bar);
            __builtin_amdgcn_fence(__ATOMIC_ACQUIRE, "agent");
            asm volatile("s_waitcnt vmcnt(0)" ::: "memory");
        }
    }
    __syncthreads();
}

__global__ void __launch_bounds__(NTHREADS, 2) hymba_fwd(Args args) {
    extern __shared__ __attribute__((aligned(16))) unsigned char lds_raw[];
    Ctx C; C.lds = (LAS unsigned char*)lds_raw; C.tid = threadIdx.x; C.lane = C.tid & 63; C.wave = __builtin_amdgcn_readfirstlane(C.tid >> 6);
    C.G = gridDim.x; C.bid = blockIdx.x; C.in = args.in; C.out = args.out; C.ws = args.ws;
    const int lo = args.ph_lo, hi = args.ph_hi;
    unsigned char* ws = args.ws;
    if (lo < 0) cg::this_grid().sync();
    volatile LAS unsigned* bst = (volatile LAS unsigned*)(C.lds + LDS_BYTES - 32);
    if (C.tid < 8) bst[C.tid] = 0u;
    __syncthreads();
    XcdBarrier bar = xcd_barrier_post((unsigned*)(ws + WS_CTL) + 4096, bst);
#ifndef PH_MASK
#define PH_MASK 0x1ff
#endif
#define IN(k) (((PH_MASK >> (k)) & 1) && lo <= (k) && (k) < hi)
#define SEAM(k) do { if (lo <= (k) && (k) + 1 < hi) xcd_barrier(bar); } while (0)
#ifndef REP_MASK
#define REP_MASK 0
#endif
#define REPS(k) for (int rep_ = 0; rep_ <= ((REP_MASK >> (k)) & 1); ++rep_)
#define REP_SYNC(k) do { if (((REP_MASK >> (k)) & 1) && rep_ == 0) xcd_barrier(bar); } while (0)

    if (IN(0)) REPS(0) { p0_prologue(C); REP_SYNC(0); }
    SEAM(0);
    if (IN(1)) REPS(1) {
        pg8::Gemm g{(const bf16_t*)(ws + WS_XB), (const bf16_t*)(ws + WS_WIN), MT, INC, DM}; pg8::ComboOrder S; S.init(MP, INC, DM, 1, C.G, C.bid);
        EpiIn E{(bf16_t*)(ws + WS_QP), (bf16_t*)(ws + WS_KP), (bf16_t*)(ws + WS_VP), (bf16_t*)(ws + WS_QS), (float*)(ws + WS_XBR), (bf16_t*)(ws + WS_GB), args.out, (const float*)(ws + WS_ROPE)};
        pg8::gemm_phase<EpiIn, pg8::ComboOrder, true, true>(C.lds, g, S, E); REP_SYNC(1);
    }
    SEAM(1);
    if (IN(2)) REPS(2) {
        float lam;
        { const float a = args.in[7][C.lane] * args.in[8][C.lane], b2 = args.in[9][C.lane] * args.in[10][C.lane];
          lam = expf(wave_sum(a)) - expf(wave_sum(b2)) + LAM_INIT; }
        unsigned* ctr = (unsigned*)(ws + WS_CTL) + 64 * rep_;
        LAS unsigned* slot = (LAS unsigned*)(C.lds + LDS_BYTES - 64);
        for (;;) {
            if (C.tid == 0) slot[0] = atomicAdd(ctr, 1u);
            asm volatile("s_waitcnt vmcnt(0) lgkmcnt(0)" ::: "memory");
            __builtin_amdgcn_s_barrier();
            asm volatile("" ::: "memory");
            const int item = (int)__builtin_amdgcn_readfirstlane(slot[0]);
            asm volatile("s_waitcnt lgkmcnt(0)" ::: "memory");
            __builtin_amdgcn_s_barrier();
            asm volatile("" ::: "memory");
            if (item >= 32 + 128 + 512 + 16) break;
#ifndef P2_MASK
#define P2_MASK 15
#endif
            if (item < 32) { if (P2_MASK & 1) lru_unit<false>(C, item >> 4, item & 15); }
            else if (item < 160) { if (P2_MASK & 2) { const int k = item - 32; attn_sample_unit(C, k >> 3, k & 7, lam); } }
            else if (item < 672) { if (P2_MASK & 4) { const int k = item - 160; const int qi = 31 - (k >> 4), bh = k & 15; attn_prompt_unit(C, bh >> 3, bh & 7, qi, lam); } }
            else { if (P2_MASK & 8) lru_unit<true>(C, 0, item - 672); }
        }
        REP_SYNC(2);
    }
    SEAM(2);
    if (IN(3)) REPS(3) {
        pg8::Gemm g{(const bf16_t*)(ws + WS_CAT), (const bf16_t*)(ws + WS_WOUT), MT, DM, DM}; pg8::ComboOrder S; S.init(MP, DM, DM, KS3, C.G, C.bid);
        EpiAxpy E{args.in[0], (float*)(ws + WS_Y1), (float*)(ws + WS_PART3)};
        pg8::gemm_phase<EpiAxpy, pg8::ComboOrder, true, true>(C.lds, g, S, E); REP_SYNC(3);
    }
    SEAM(3);
    if (IN(4)) { ln_rows(C, (const float*)(ws + WS_Y1), (float*)(ws + WS_Y1), (bf16_t*)(ws + WS_X1B), args.in[20], args.in[21], args.in[1], (const float*)(ws + WS_PART3), KS3); }
    SEAM(4);
    if (IN(5)) REPS(5) {
        pg8::Gemm g{(const bf16_t*)(ws + WS_X1B), (const bf16_t*)(ws + WS_WUP), MT, DFF, DM}; pg8::ComboOrder S; S.init(MP, DFF, DM, KS5, C.G, C.bid);
        EpiUp E{(bf16_t*)(ws + WS_H), (float*)(ws + WS_PART5)};
        pg8::gemm_phase<EpiUp, pg8::ComboOrder, true, true>(C.lds, g, S, E); REP_SYNC(5);
    }
    SEAM(5);
    if (IN(6)) { reduce_up_sample(C); }
    SEAM(6);
    if (IN(7)) REPS(7) {
        pg8::Gemm g{(const bf16_t*)(ws + WS_H), (const bf16_t*)(ws + WS_WDOWN), MT, DM, DFF}; pg8::ComboOrder S; S.init(MP, DM, DFF, KS6, C.G, C.bid);
        EpiAxpy E{(const float*)(ws + WS_Y1), args.out, (float*)(ws + WS_PART6)};
        pg8::gemm_phase<EpiAxpy, pg8::ComboOrder, true, true>(C.lds, g, S, E); REP_SYNC(7);
    }
    SEAM(7);
#ifndef EXTRA_SYNCS
#define EXTRA_SYNCS 0
#endif
    for (int es_ = 0; es_ < EXTRA_SYNCS; ++es_) xcd_barrier(bar);
    if (IN(8)) { ln_rows(C, args.out, args.out, nullptr, args.in[24], args.in[25], (const float*)(ws + WS_Y1) + (size_t)MP * DM, (const float*)(ws + WS_PART6), KS6); }
#undef IN
#undef SEAM
}

extern "C" void kernel_launch(void* const* d_in, const int* in_sizes, int n_in, void* d_out, int out_size, void* d_ws, size_t ws_size, hipStream_t stream) {
    static int grid = 0;
    if (grid == 0) {
        if (n_in != 26 || out_size != (int)O_END || ws_size < WS_END) { fprintf(stderr, "kernel_launch: unexpected shapes: n_in %d out %d ws %zu\n", n_in, out_size, ws_size); grid = -1; return; }
        int dev = 0, cus = 0, per_cu = 0;
        hipGetDevice(&dev); hipDeviceGetAttribute(&cus, hipDeviceAttributeMultiprocessorCount, dev);
        if (hipFuncSetAttribute((const void*)hymba_fwd, hipFuncAttributeMaxDynamicSharedMemorySize, LDS_BYTES) != hipSuccess) { fprintf(stderr, "kernel_launch: hipFuncSetAttribute failed\n"); grid = -1; return; }
        hipOccupancyMaxActiveBlocksPerMultiprocessor(&per_cu, (const void*)hymba_fwd, NTHREADS, LDS_BYTES);
        if (per_cu < 1) { fprintf(stderr, "kernel_launch: occupancy query says %d blocks per CU\n", per_cu); grid = -1; return; }
        grid = cus;
        fprintf(stderr, "kernel_launch: %d CUs, occupancy %d blocks/CU, grid %d\n", cus, per_cu, grid);
    }
    if (grid < 0) return;
    hipMemsetAsync((char*)d_ws + WS_CTL, 0, CTL_BYTES, stream);
    Args a{};
    for (int i = 0; i < 26; ++i) a.in[i] = (const float*)d_in[i];
    a.out = (float*)d_out; a.ws = (unsigned char*)d_ws;
    constexpr int NPH = 9;
    for (int li = 0; li < MK_N_LAUNCHES; ++li) {
        a.ph_lo = (MK_N_LAUNCHES == 1) ? 0 : li; a.ph_hi = (MK_N_LAUNCHES == 1) ? NPH : li + 1;
        void* kargs[] = {&a};
        hipError_t e = hipLaunchCooperativeKernel((const void*)hymba_fwd, dim3(grid), dim3(NTHREADS), kargs, LDS_BYTES, stream);
        if (e != hipSuccess) { fprintf(stderr, "kernel_launch: cooperative launch %d failed: %s\n", li, hipGetErrorString(e)); break; }
    }
}
```
